# Optimizing an MI355X kernel written in HIP

```python
import math
import jax, jax.numpy as jnp
from jax import lax
import numpy as np

D_MODEL = 1024
BATCH = 4
SEQ = 8192
DEPTH = 2

CHUNK = 64
D_MIX = D_MODEL
DN_HEADS = 4
DN_HEAD_DIM = 128
DN_WIDTH = DN_HEADS * DN_HEAD_DIM
SHORT_CONV = 4
CONF_WIDTH = D_MIX - DN_WIDTH
CONF_KERNEL = 31
C_IN = 4 * DN_WIDTH + 2 * DN_HEADS + 2 * CONF_WIDTH
N_GROUPS = 4
EXPERTS_PER_GROUP = 8
N_EXPERTS = N_GROUPS * EXPERTS_PER_GROUP
TOP_K = 2
D_EXPERT = 512
MOE_BLOCK = 128
EPS = 1e-6

kernel_name = 'hybrid_deltanet_conformer_hiermoe'


def rmsnorm(x, w):
    xf = x.astype(jnp.float32)
    y = xf * lax.rsqrt(jnp.mean(xf * xf, axis=-1, keepdims=True) + EPS)
    return (y * w.astype(jnp.float32)).astype(x.dtype)


def layernorm(x, g, b):
    xf = x.astype(jnp.float32)
    mu = jnp.mean(xf, axis=-1, keepdims=True)
    var = jnp.mean(jnp.square(xf - mu), axis=-1, keepdims=True)
    y = (xf - mu) * lax.rsqrt(var + EPS) * g.astype(jnp.float32) + b.astype(jnp.float32)
    return y.astype(x.dtype)


def l2norm(x):
    return x * lax.rsqrt(jnp.sum(x * x, axis=-1, keepdims=True) + EPS)


def causal_dwconv(x, w):
    K, C = w.shape
    return lax.conv_general_dilated(
        x, w[:, None, :].astype(x.dtype), window_strides=(1,), padding=[(K - 1, 0)],
        dimension_numbers=('NWC', 'WIO', 'NWC'), feature_group_count=C)


def chunked_gated_delta_rule(q, k, v, g, beta):
    Bn, L, H, dk = q.shape
    dv = v.shape[-1]
    N = L // CHUNK
    q = l2norm(q) * (dk ** -0.5)
    k = l2norm(k)

    def to_chunks(t):
        t = t.reshape((Bn, N, CHUNK, H) + t.shape[3:])
        return jnp.moveaxis(t, 3, 1)

    qc, kc, vc, gc, bc = (to_chunks(t) for t in (q, k, v, g, beta))
    gc = jnp.cumsum(gc, axis=-1)
    incl = jnp.tril(jnp.ones((CHUNK, CHUNK), bool))
    strict = jnp.tril(jnp.ones((CHUNK, CHUNK), bool), -1)
    decay = jnp.exp(jnp.where(incl, gc[..., :, None] - gc[..., None, :], -jnp.inf))
    a_mat = jnp.where(strict, bc[..., :, None] * jnp.einsum('bhncd,bhnsd->bhncs', kc, kc) * decay, 0.0)
    rhs = jnp.concatenate([bc[..., None] * vc, (bc * jnp.exp(gc))[..., None] * kc], axis=-1)
    sol = lax.linalg.triangular_solve(a_mat + jnp.eye(CHUNK, dtype=a_mat.dtype), rhs,
                                      left_side=True, lower=True, unit_diagonal=True)
    u_c, w_c = sol[..., :dv], sol[..., dv:]
    qk = jnp.einsum('bhncd,bhnsd->bhncs', qc, kc) * decay
    q_dec = qc * jnp.exp(gc)[..., None]
    k_dec = kc * jnp.exp(gc[..., -1:] - gc)[..., None]
    g_last = jnp.exp(gc[..., -1])
    xs = tuple(jnp.moveaxis(t, 2, 0) for t in (q_dec, k_dec, u_c, w_c, qk, g_last))

    def step(S, inp):
        q_i, k_i, u_i, w_i, qk_i, gl_i = inp
        v_new = u_i - jnp.einsum('bhcd,bhde->bhce', w_i, S)
        o_i = jnp.einsum('bhcd,bhde->bhce', q_i, S) + jnp.einsum('bhcs,bhse->bhce', qk_i, v_new)
        S = S * gl_i[..., None, None] + jnp.einsum('bhcd,bhce->bhde', k_i, v_new)
        return S, o_i

    S0 = jnp.zeros((Bn, H, dk, dv), jnp.float32)
    _, o = lax.scan(step, S0, xs)
    o = jnp.moveaxis(o, 0, 2)
    return jnp.moveaxis(o, 1, 3).reshape(Bn, L, H, dv)


def gated_deltanet(qkv, z, b_logit, a_logit, conv_w, a_log, dt_bias, o_norm):
    Bn, L, _ = qkv.shape
    out_dtype = qkv.dtype
    qkv = jax.nn.silu(causal_dwconv(qkv, conv_w)).astype(jnp.float32)
    q, k, v = jnp.split(qkv, 3, axis=-1)
    hs = (Bn, L, DN_HEADS, DN_HEAD_DIM)
    q, k, v = q.reshape(hs), k.reshape(hs), v.reshape(hs)
    beta = jax.nn.sigmoid(b_logit.astype(jnp.float32))
    g = -jnp.exp(a_log.astype(jnp.float32)) * jax.nn.softplus(
        a_logit.astype(jnp.float32) + dt_bias.astype(jnp.float32))
    o = chunked_gated_delta_rule(q, k, v, g, beta)
    o = o * lax.rsqrt(jnp.mean(o * o, axis=-1, keepdims=True) + EPS) * o_norm.astype(jnp.float32)
    o = o * jax.nn.silu(z.astype(jnp.float32).reshape(hs))
    return o.reshape(Bn, L, DN_WIDTH).astype(out_dtype)


def conformer_conv(u, w_dw, b_dw, ln_g, ln_b):
    glu = u[..., :CONF_WIDTH] * jax.nn.sigmoid(u[..., CONF_WIDTH:])
    c = causal_dwconv(glu, w_dw) + b_dw.astype(glu.dtype)
    c = layernorm(c, ln_g, ln_b)
    return jax.nn.silu(c)


def hier_moe(h, w_rg, b_rg, w_re, b_re, w_gate, w_up, w_down):
    T, D = h.shape
    hf = h.astype(jnp.float32)
    p_grp = jax.nn.softmax(hf @ w_rg.astype(jnp.float32) + b_rg.astype(jnp.float32), axis=-1)
    p_g, g_sel = lax.top_k(p_grp, 1)
    e_logits = (hf @ w_re.astype(jnp.float32) + b_re.astype(jnp.float32)).reshape(
        T, N_GROUPS, EXPERTS_PER_GROUP)
    e_logits = jnp.take_along_axis(e_logits, g_sel[:, :, None], axis=1)[:, 0]
    p_e = jax.nn.softmax(e_logits, axis=-1)
    top_p, top_i = lax.top_k(p_e, TOP_K)
    gates = p_g * top_p / jnp.sum(top_p, axis=-1, keepdims=True)
    expert_id = g_sel * EXPERTS_PER_GROUP + top_i

    A = T * TOP_K
    flat_e = expert_id.reshape(A)
    flat_tok = jnp.repeat(jnp.arange(T, dtype=jnp.int32), TOP_K)
    flat_w = gates.reshape(A)
    order = jnp.argsort(flat_e)
    e_s, tok_s, w_s = flat_e[order], flat_tok[order], flat_w[order]
    counts = jnp.bincount(flat_e, length=N_EXPERTS)
    padded = (counts + MOE_BLOCK - 1) // MOE_BLOCK * MOE_BLOCK
    starts = jnp.cumsum(counts) - counts
    pad_ends = jnp.cumsum(padded)
    pad_starts = pad_ends - padded
    dest = pad_starts[e_s] + jnp.arange(A, dtype=jnp.int32) - starts[e_s]
    n_blocks = -(-(A + N_EXPERTS * MOE_BLOCK) // MOE_BLOCK)
    P = n_blocks * MOE_BLOCK
    slot_tok = jnp.full((P,), T, jnp.int32).at[dest].set(tok_s)
    block_expert = jnp.minimum(
        jnp.searchsorted(pad_ends, jnp.arange(n_blocks, dtype=jnp.int32) * MOE_BLOCK, side='right'),
        N_EXPERTS - 1)
    h_pad = jnp.concatenate([h, jnp.zeros((1, D), h.dtype)], axis=0)

    def run_block(args):
        toks, e = args
        xb = h_pad[toks]
        return (jax.nn.silu(xb @ w_gate[e]) * (xb @ w_up[e])) @ w_down[e]

    y = lax.map(run_block, (slot_tok.reshape(n_blocks, MOE_BLOCK), block_expert)).reshape(P, D)
    return jnp.zeros_like(h).at[tok_s].add(y[dest] * w_s[:, None].astype(h.dtype))


def setup_inputs(seed: int = 0) -> dict:
    key = jax.random.key(seed)
    ks = jax.random.split(key, 21)
    f32 = jnp.float32

    def nrm(k, shape, scale):
        return jax.random.normal(k, shape, f32) * scale

    def gain(k, shape):
        return 1.0 + 0.01 * jax.random.normal(k, shape, f32)

    x = nrm(ks[0], (BATCH, SEQ, D_MODEL), 1.0)
    norm_mix = gain(ks[1], (DEPTH, D_MODEL))
    w_in = nrm(ks[2], (DEPTH, D_MODEL, C_IN), D_MODEL ** -0.5)
    conv_qkv = nrm(ks[3], (DEPTH, SHORT_CONV, 3 * DN_WIDTH), SHORT_CONV ** -0.5)
    a_log = jnp.log(jax.random.uniform(ks[4], (DEPTH, DN_HEADS), f32, 1.0, 16.0))
    dt = jnp.exp(jax.random.uniform(ks[5], (DEPTH, DN_HEADS), f32, math.log(1e-3), math.log(1e-1)))
    dt_bias = dt + jnp.log(-jnp.expm1(-dt))
    o_norm = gain(ks[6], (DEPTH, DN_HEAD_DIM))
    w_dw = nrm(ks[7], (DEPTH, CONF_KERNEL, CONF_WIDTH), CONF_KERNEL ** -0.5)
    b_dw = nrm(ks[8], (DEPTH, CONF_WIDTH), 0.01)
    ln_g = gain(ks[9], (DEPTH, CONF_WIDTH))
    ln_b = nrm(ks[10], (DEPTH, CONF_WIDTH), 0.01)
    w_out = nrm(ks[11], (DEPTH, D_MIX, D_MODEL), D_MIX ** -0.5)
    norm_ffn = gain(ks[12], (DEPTH, D_MODEL))
    w_rg = nrm(ks[13], (DEPTH, D_MODEL, N_GROUPS), D_MODEL ** -0.5)
    b_rg = nrm(ks[14], (DEPTH, N_GROUPS), 0.01)
    w_re = nrm(ks[15], (DEPTH, D_MODEL, N_EXPERTS), D_MODEL ** -0.5)
    b_re = nrm(ks[16], (DEPTH, N_EXPERTS), 0.01)
    w_gate = nrm(ks[17], (DEPTH, N_EXPERTS, D_MODEL, D_EXPERT), D_MODEL ** -0.5)
    w_up = nrm(ks[18], (DEPTH, N_EXPERTS, D_MODEL, D_EXPERT), D_MODEL ** -0.5)
    w_down = nrm(ks[19], (DEPTH, N_EXPERTS, D_EXPERT, D_MODEL), D_EXPERT ** -0.5)
    norm_final = gain(ks[20], (D_MODEL,))
    return {'x': x, 'norm_mix': norm_mix, 'w_in': w_in, 'conv_qkv': conv_qkv, 'a_log': a_log,
            'dt_bias': dt_bias, 'o_norm': o_norm, 'w_dw': w_dw, 'b_dw': b_dw, 'ln_g': ln_g,
            'ln_b': ln_b, 'w_out': w_out, 'norm_ffn': norm_ffn, 'w_rg': w_rg, 'b_rg': b_rg,
            'w_re': w_re, 'b_re': b_re, 'w_gate': w_gate, 'w_up': w_up, 'w_down': w_down,
            'norm_final': norm_final}


def reference(x, norm_mix, w_in, conv_qkv, a_log, dt_bias, o_norm, w_dw, b_dw, ln_g, ln_b,
              w_out, norm_ffn, w_rg, b_rg, w_re, b_re, w_gate, w_up, w_down, norm_final):
    Bn, L, D = x.shape
    o_z = 3 * DN_WIDTH
    o_b = 4 * DN_WIDTH
    o_a = o_b + DN_HEADS
    o_c = o_a + DN_HEADS
    for l in range(DEPTH):
        h = rmsnorm(x, norm_mix[l])
        u = h @ w_in[l]
        y_dn = gated_deltanet(u[..., :o_z], u[..., o_z:o_b], u[..., o_b:o_a], u[..., o_a:o_c],
                              conv_qkv[l], a_log[l], dt_bias[l], o_norm[l])
        y_cf = conformer_conv(u[..., o_c:], w_dw[l], b_dw[l], ln_g[l], ln_b[l])
        x = x + (jnp.concatenate([y_dn, y_cf], axis=-1) @ w_out[l]).astype(x.dtype)
        h = rmsnorm(x, norm_ffn[l])
        y = hier_moe(h.reshape(Bn * L, D), w_rg[l], b_rg[l], w_re[l], b_re[l],
                     w_gate[l], w_up[l], w_down[l])
        x = x + y.reshape(Bn, L, D).astype(x.dtype)
    return rmsnorm(x, norm_final)
```

```cpp
#include <hip/hip_runtime.h>
#include <cstdio>
#include <cstdint>

#ifndef MK_PER_PHASE
#define MK_PER_PHASE 0
#endif

#define LAS __attribute__((address_space(3)))
#define GAS __attribute__((address_space(1)))
typedef unsigned short bf16_t;
typedef short bf16x8 __attribute__((ext_vector_type(8)));
typedef float f32x4 __attribute__((ext_vector_type(4)));
typedef float f32x2 __attribute__((ext_vector_type(2)));
typedef unsigned u32x4 __attribute__((ext_vector_type(4)));
typedef unsigned u32x2 __attribute__((ext_vector_type(2)));
typedef int i32x4 __attribute__((ext_vector_type(4)));
typedef int i32x8 __attribute__((ext_vector_type(8)));
typedef __bf16 bf16x2_t __attribute__((ext_vector_type(2)));
#define DI __device__ __forceinline__

constexpr int T_TOK = 32768, DM = 1024, SEQ = 8192, NHEAD = 4, DH = 128, CHK = 64, NCHUNK = 128;
constexpr int CIN = 3080, UW = 2560;
constexpr int NEXP = 32, DEXP = 512, LCAP = 32768;
constexpr float EPS = 1e-6f;
constexpr int NWAVES = 8, NTHR = 512;

constexpr size_t MiB = 1u << 20;
constexpr size_t WS_CTL = 0, CTL_BYTES = 64 * 1024;
constexpr size_t WS_WSM1 = 1 * MiB;
constexpr size_t WS_WSM2 = 1 * MiB + 128 * 1024;
constexpr size_t WS_RSTD = 2 * MiB;
constexpr size_t WS_G = 2 * MiB + 256 * 1024;
constexpr size_t WS_BETA = 3 * MiB;
constexpr size_t WS_TOKEP = 3 * MiB + 512 * 1024;
constexpr size_t WS_PSQ = 4 * MiB;
constexpr size_t WS_LIST = 8 * MiB;
constexpr size_t WS_GATEL = 12 * MiB;
constexpr size_t WS_RSTDL = 16 * MiB;
constexpr size_t WS_WIN = 20 * MiB;
constexpr size_t WS_WOUT = 32 * MiB;
constexpr size_t WS_WGU = 36 * MiB;
constexpr size_t WS_WDN = 100 * MiB;
constexpr size_t WS_RA = 132 * MiB;
constexpr size_t WS_X8 = WS_RA;
constexpr size_t WS_A8 = 68 * MiB;
constexpr size_t WS_HID = WS_RA + 64 * MiB;
constexpr size_t WS_RB = 288 * MiB;
constexpr size_t WS_PG = 448 * MiB;
constexpr size_t WS_QG = 456 * MiB;
constexpr size_t WS_XR = 472 * MiB;
constexpr size_t WS_END = 536 * MiB;
constexpr int DN_K = 0, DN_KT = 16384, DN_Q = 32768, DN_T = 49152, DN_QK = 55296, DN_V = 61440, DN_G = 77824, DN_BYTES = 78848;
constexpr int CW_BAR = 0, CW_CNT = 4096;
constexpr int CW_QHEAD = 8192 + 64, CW_DONE = 8192 + 128;

constexpr int STAGE_BYTES = 131072;
constexpr int C1_WAVE_BYTES = 18432;
constexpr int C1_EXTRA = 8 * C1_WAVE_BYTES;
constexpr int LDS_BYTES = 163840;
constexpr int MISC_OFF = LDS_BYTES - 2048;
constexpr int MS_BAR = 0;
constexpr int MS_CNT = 64;
constexpr int MS_TST = 256;
constexpr int MS_LCNT = 512;
constexpr int MS_GBASE = 768;
constexpr int MS_WAVE = 0;
constexpr int MS_CONVW = 4096;
constexpr int RING_IMG = 78848;
static_assert(2 * RING_IMG <= MISC_OFF && C1_EXTRA + MS_CONVW + 6144 <= MISC_OFF, "LDS map");

DI unsigned pk2(float a, float b) { f32x2 v = {a, b}; bf16x2_t r = __builtin_convertvector(v, bf16x2_t); return __builtin_bit_cast(unsigned, r); }
DI unsigned pk4f8(float a, float b, float c, float d) {
    a = __builtin_amdgcn_fmed3f(a, -448.f, 448.f); b = __builtin_amdgcn_fmed3f(b, -448.f, 448.f); c = __builtin_amdgcn_fmed3f(c, -448.f, 448.f); d = __builtin_amdgcn_fmed3f(d, -448.f, 448.f);
    int r = __builtin_amdgcn_cvt_pk_fp8_f32(a, b, 0, false); r = __builtin_amdgcn_cvt_pk_fp8_f32(c, d, r, true); return (unsigned)r; }
constexpr float F8_SX = 4.f, F8_SW1 = 64.f, F8_SH = 8.f, F8_SW2 = 32.f, F8_SY = 64.f, F8_SA = 8.f, F8_SWO = 64.f;
constexpr float F8_SWI = 64.f;
constexpr bool G1F8 = true;
constexpr int G2F8_L = 1;
DI f32x4 f8x4(unsigned w) { const f32x2 lo = __builtin_amdgcn_cvt_pk_f32_fp8((int)w, false), hi = __builtin_amdgcn_cvt_pk_f32_fp8((int)w, true); return (f32x4){lo[0], lo[1], hi[0], hi[1]}; }
DI float bflo(unsigned u) { return __builtin_bit_cast(float, u << 16); }
DI float bfhi(unsigned u) { return __builtin_bit_cast(float, u & 0xffff0000u); }
DI float wave_sum(float v) {
#pragma unroll
    for (int o = 1; o < 64; o <<= 1) v += __shfl_xor(v, o);
    return v;
}
template <int N> DI float dpp_ror_(float v) { return __builtin_bit_cast(float, __builtin_amdgcn_update_dpp(0, __builtin_bit_cast(int, v), 0x120 + N, 0xf, 0xf, false)); }
DI float row_sum16(float v) { v += dpp_ror_<8>(v); v += dpp_ror_<4>(v); v += dpp_ror_<2>(v); v += dpp_ror_<1>(v); return v; }
DI float siluf(float x) { return x * __builtin_amdgcn_rcpf(1.0f + __expf(-x)); }
DI float sigmoidf_(float x) { return __builtin_amdgcn_rcpf(1.0f + __expf(-x)); }
DI f32x4 silu4(const f32x4 a) {
    const f32x4 t = a * -1.44269504f;
    f32x4 d = {__builtin_amdgcn_exp2f(t[0]), __builtin_amdgcn_exp2f(t[1]), __builtin_amdgcn_exp2f(t[2]), __builtin_amdgcn_exp2f(t[3])}; d = d + 1.0f;
    const f32x4 r = {__builtin_amdgcn_rcpf(d[0]), __builtin_amdgcn_rcpf(d[1]), __builtin_amdgcn_rcpf(d[2]), __builtin_amdgcn_rcpf(d[3])};
    return a * r; }
#define LDS_WAIT() asm volatile("s_waitcnt lgkmcnt(0)" ::: "memory")
#define VM_WAIT() asm volatile("s_waitcnt vmcnt(0)" ::: "memory")
DI bf16x8 mk8(unsigned a, unsigned b, unsigned c, unsigned d) { u32x4 v = {a, b, c, d}; return __builtin_bit_cast(bf16x8, v); }
DI bf16x8 pack8(const f32x4& lo, const f32x4& hi) { return mk8(pk2(lo[0], lo[1]), pk2(lo[2], lo[3]), pk2(hi[0], hi[1]), pk2(hi[2], hi[3])); }
#define MFMA16(a, b, c) __builtin_amdgcn_mfma_f32_16x16x32_bf16((a), (b), (c), 0, 0, 0)
typedef __amdgpu_buffer_rsrc_t rsrc_t;
DI rsrc_t mk_rsrc(const void* p, unsigned bytes) { return __builtin_amdgcn_make_buffer_rsrc((void*)p, (short)0, (int)bytes, 0x00020000); }
#define BST128(v, rs, voff, soff) __builtin_amdgcn_raw_buffer_store_b128(__builtin_bit_cast(u32x4, (v)), (rs), (voff), (soff), 0)
#define BST64(v, rs, voff, soff) __builtin_amdgcn_raw_buffer_store_b64(__builtin_bit_cast(u32x2, (v)), (rs), (voff), (soff), 0)
#define BLD128(rs, voff, soff) __builtin_bit_cast(bf16x8, __builtin_amdgcn_raw_buffer_load_b128((rs), (voff), (soff), 0))
#define BLD64(rs, voff, soff) __builtin_amdgcn_raw_buffer_load_b64((rs), (voff), (soff), 0)

#define XB_TMO      128
#define XB_XCNT(j)  (256  + 64 * (j))
#define XB_XSUB(j)  (1280 + 64 * (j))
#define XB_XGEN(j)  (2304 + 64 * (j))
#define XB_TOP      3328
#define XB_TOPGEN   3392
#define XCD_BAR_WORDS 3456
#define XB_SPIN_CAP (1u << 18)
DI unsigned xb_ld(unsigned* p)              { return __hip_atomic_load(p, __ATOMIC_RELAXED, __HIP_MEMORY_SCOPE_AGENT); }
DI unsigned xb_add(unsigned* p, unsigned v) { return __hip_atomic_fetch_add(p, v, __ATOMIC_RELAXED, __HIP_MEMORY_SCOPE_AGENT); }
DI unsigned xb_xcc_id() { return (unsigned)__builtin_amdgcn_s_getreg((3 << 11) | 20) & 0xFu; }
#define XB_SPIN(cond, bar) do { unsigned _sp = 0; while (cond) { __builtin_amdgcn_s_sleep(1); \
    if ((++_sp & 255u) == 0u) { if (xb_ld(&(bar)[XB_TMO])) break; if (_sp > XB_SPIN_CAP) { atomicAdd(&(bar)[XB_TMO], 1u); break; } } } } while (0)
struct XcdBarrier { unsigned* bar; unsigned x; volatile LAS unsigned* st; };
DI XcdBarrier xcd_barrier_post(unsigned* bar, volatile LAS unsigned* st) {
    XcdBarrier b; b.bar = bar; b.x = xb_xcc_id(); b.st = st;
    if (threadIdx.x == 0) (void)xb_add(&bar[XB_XCNT(b.x)], 1u);
    return b;
}
DI void xcd_barrier_complete(unsigned* bar, unsigned x, unsigned& nloc, unsigned& nx) {
    const unsigned G = gridDim.x * gridDim.y * gridDim.z;
    unsigned sum, cnt, mine, sp = 0u;
    for (;;) {
        sum = 0u; cnt = 0u; mine = 0u;
#pragma unroll
        for (unsigned j = 0; j < 16; ++j) { const unsigned c = xb_ld(&bar[XB_XCNT(j)]); sum += c; cnt += (c > 0u) ? 1u : 0u; mine = (j == x) ? c : mine; }
        if (sum == G) break;
        __builtin_amdgcn_s_sleep(1);
        if ((++sp & 255u) == 0u) { if (xb_ld(&bar[XB_TMO])) break; if (sp > XB_SPIN_CAP) { atomicAdd(&bar[XB_TMO], 1u); break; } }
    }
    nloc = mine > 0u ? mine : 1u; nx = cnt > 0u ? cnt : 1u;
}
DI void xcd_barrier(const XcdBarrier& b) {
    asm volatile("s_waitcnt vmcnt(0)" ::: "memory");
    __syncthreads();
    if (threadIdx.x == 0) {
        unsigned* bar = b.bar;
        __builtin_amdgcn_s_waitcnt(0);
        unsigned nloc = b.st[0], nx = b.st[1];
        if (nloc == 0u) { xcd_barrier_complete(bar, b.x, nloc, nx); b.st[0] = nloc; b.st[1] = nx; }
        const unsigned old = xb_add(&bar[XB_XSUB(b.x)], 1u);
        const unsigned gen = old / nloc;
        if (old + 1u == (gen + 1u) * nloc) {
            __builtin_amdgcn_fence(__ATOMIC_RELEASE, "agent");
            asm volatile("s_waitcnt vmcnt(0)" ::: "memory");
            const unsigned og = xb_add(&bar[XB_TOP], 1u);
            const unsigned tg = og / nx;
            if (og + 1u == (tg + 1u) * nx) xb_add(&bar[XB_TOPGEN], 1u);
            else XB_SPIN(xb_ld(&bar[XB_TOPGEN]) == tg, bar);
            __builtin_amdgcn_fence(__ATOMIC_ACQUIRE, "agent");
            xb_add(&bar[XB_XGEN(b.x)], 1u);
            asm volatile("s_waitcnt vmcnt(0)" ::: "memory");
        } else {
            XB_SPIN(xb_ld(&bar[XB_XGEN(b.x)]) == gen, bar);
            __builtin_amdgcn_fence(__ATOMIC_ACQUIRE, "agent");
            asm volatile("s_waitcnt vmcnt(0)" ::: "memory");
        }
    }
    __syncthreads();
}

struct Frame {
    LAS unsigned char* lds;
    const float* in[21];
    float* out;
    unsigned char* ws;
    int tid, lane, wave, G, bid;
};
#define IN_(FR, i) ((FR).in[i])
DI LAS int* misc_i(Frame& F, int off) { return (LAS int*)(F.lds + MISC_OFF + off); }
DI unsigned* ctl(Frame& F) { return (unsigned*)(F.ws + WS_CTL); }

namespace pg8 {
constexpr int BM = 256, BK = 64, HALF = 128, HTB = HALF * BK * 2;
DI int lds_byte(int r, int c) { const int st = (r >> 4) * 2 + (c >> 5), rr = r & 15, cc = c & 31, ob = rr * 64 + cc * 2; return st * 1024 + (ob ^ (((ob >> 9) & 1) << 5)); }
DI void stage_rc(int b, int& R, int& C) { const int st = b / 1024, sb = b % 1024, swz = sb ^ (((sb >> 9) & 1) << 5); R = (st >> 1) * 16 + swz / 64; C = (st & 1) * 32 + (swz % 64) / 2; }
DI int perm32(int rho) { const int n = rho >> 4, i = rho & 15; return 8 * (i >> 2) + 4 * n + (i & 3); }
struct Unit { int pm, pn, e, lt; };

struct DenseSched {
    static constexpr bool GATHER = false;
    const char* A; const char* Bt; int lda, K, nM, nN, nwg, G, c;
    DI void init(const void* A_, int lda_, const void* Bt_, int M, int N, int K_, int G_, int c_) { A = (const char*)A_; Bt = (const char*)Bt_; lda = lda_; K = K_; nM = M / BM; nN = N / BM; nwg = nM * nN; G = G_; c = c_; }
    DI bool next(int i, Unit& u) const {
        const long L = (long)i * G + c; if (L >= nwg) return false;
        int wgid = (int)L; { const int q = nwg / 8, r = nwg % 8, xcd = wgid % 8, off = wgid / 8; wgid = (xcd < r ? xcd * (q + 1) : r * (q + 1) + (xcd - r) * q) + off; }
        const int nig = 8 * nN, gid = wgid / nig, fm = gid * 8, gsz = (nM - fm) < 8 ? (nM - fm) : 8;
        u.pm = fm + ((wgid % nig) % gsz); u.pn = (wgid % nig) / gsz; u.e = 0; u.lt = 0; return true;
    }
    DI const char* a_ptr(const Unit& u) const { return A + (size_t)u.pm * BM * lda * 2; }
    DI const char* b_ptr(const Unit& u) const { return Bt + (size_t)u.pn * BM * K * 2; }
    DI void a_off(const Unit&, const int (&R)[2], const int (&C)[2], unsigned (&v)[2][2]) const {
#pragma unroll
        for (int h = 0; h < 2; ++h)
#pragma unroll
            for (int i = 0; i < 2; ++i) v[h][i] = (unsigned)((h * HALF + R[i]) * lda + C[i]) * 2u;
    }
};
template <bool GATHER_> struct GroupSched {
    static constexpr bool GATHER = GATHER_;
    const char* A; const char* Bt; const unsigned* list; LAS const int* tst; LAS const int* cnt; int K, ntile, G, c;
    DI bool next(int i, Unit& u) const {
        int L = i * G + c;
        if (G == 256 && (i + 1) * 256 <= ntile * 4) { const int x = c & 7, j = c >> 3; L = i * 256 + (((x * 8) + (j >> 2)) << 2) + (j & 3); }
        if (L >= ntile * 4) return false;
        const int rt = L >> 2; int e = 0;
#pragma unroll 1
        for (int j = 16; j >= 1; j >>= 1) if (e + j < NEXP && tst[e + j] <= rt) e += j;
        u.pm = rt; u.pn = L & 3; u.e = e; u.lt = rt - tst[e]; return true;
    }
    DI const char* a_ptr(const Unit& u) const { return GATHER ? A : A + (size_t)u.pm * BM * K * 2; }
    DI const char* b_ptr(const Unit& u) const { return Bt + ((size_t)u.e * 1024 + (size_t)u.pn * BM) * K * 2; }
    DI void a_off(const Unit& u, const int (&R)[2], const int (&C)[2], unsigned (&v)[2][2]) const {
        if (GATHER) {
            const int ce = cnt[u.e];
#pragma unroll
            for (int h = 0; h < 2; ++h)
#pragma unroll
                for (int i = 0; i < 2; ++i) { int rin = u.lt * BM + h * HALF + R[i]; rin = rin < ce ? rin : ce - 1; const unsigned tok = list[(size_t)u.e * LCAP + rin]; v[h][i] = (tok * (unsigned)K + (unsigned)C[i]) * 2u; }
        } else {
#pragma unroll
            for (int h = 0; h < 2; ++h)
#pragma unroll
                for (int i = 0; i < 2; ++i) v[h][i] = (unsigned)((h * HALF + R[i]) * K + C[i]) * 2u;
        }
    }
};

template <bool F8> DI void mma2(const bf16x8 b0, const bf16x8 b1, const bf16x8 a0, const bf16x8 a1, f32x4& c) {
    if (F8) { const i32x8 B = __builtin_shufflevector(__builtin_bit_cast(i32x4, b0), __builtin_bit_cast(i32x4, b1), 0, 1, 2, 3, 4, 5, 6, 7), A = __builtin_shufflevector(__builtin_bit_cast(i32x4, a0), __builtin_bit_cast(i32x4, a1), 0, 1, 2, 3, 4, 5, 6, 7);
        asm volatile("v_mfma_f32_16x16x128_f8f6f4 %0, %1, %2, %0" : "+v"(c) : "v"(B), "v"(A)); }
    else { c = __builtin_amdgcn_mfma_f32_16x16x32_bf16(b0, a0, c, 0, 0, 0); c = __builtin_amdgcn_mfma_f32_16x16x32_bf16(b1, a1, c, 0, 0, 0); }
}
template <bool F8, class Epi, class Sched>
DI void gemm_phase(LAS unsigned char* lds, const int K, const Sched& S, const Epi& E) {
    const int tid = threadIdx.x, wid = __builtin_amdgcn_readfirstlane(tid >> 6), lane = tid & 63, wr = wid >> 2, wc = wid & 3, fr = lane & 15, fq = lane >> 4;
    const int nt = K / BK;
    int R[2], C[2]; unsigned voffB[2];
#pragma unroll
    for (int i = 0; i < 2; ++i) { stage_rc(tid * 16 + i * 8192, R[i], C[i]); const int Rb = Epi::PERM ? ((R[i] & ~31) + perm32(R[i] & 31)) : R[i]; voffB[i] = (unsigned)(Rb * K + C[i]) * 2u; }
    const size_t kstep = (size_t)(BK * 2);
    const size_t hstepB = (size_t)HALF * K * 2;
    const unsigned ldsw = (unsigned)wid * 1024u;
    const int aoff = lds_byte(wr * 64 + fr, fq * 8), boff = lds_byte(wc * 32 + fr, fq * 8);
#define PG8_SA(b, h) (((b) * 2 + (h)) * HTB)
#define PG8_SB(b, h) ((4 + (b) * 2 + (h)) * HTB)
#define PG8_STAGEB(bufoff, gbase) do { _Pragma("unroll") for (int _i = 0; _i < 2; ++_i) \
        __builtin_amdgcn_global_load_lds((const unsigned*)((const char*)(gbase) + voffB[_i]), (LAS unsigned*)(lds + (bufoff) + ldsw + _i * 8192), 16, 0, 0); } while (0)
#define PG8_STAGEA(bufoff, gbase, vv, h) do { _Pragma("unroll") for (int _i = 0; _i < 2; ++_i) \
        __builtin_amdgcn_global_load_lds((const unsigned*)((const char*)(gbase) + (vv)[h][_i]), (LAS unsigned*)(lds + (bufoff) + ldsw + _i * 8192), 16, 0, 0); } while (0)
#define PG8_LDA(dst, b, h) do { _Pragma("unroll") for (int m = 0; m < 4; ++m) _Pragma("unroll") for (int k = 0; k < 2; ++k) dst[m][k] = *(const LAS bf16x8*)(lds + PG8_SA(b, h) + aoff + m * 2048 + k * 1024); } while (0)
#define PG8_LDB(dst, b, h) do { _Pragma("unroll") for (int n = 0; n < 2; ++n) _Pragma("unroll") for (int k = 0; k < 2; ++k) dst[n][k] = *(const LAS bf16x8*)(lds + PG8_SB(b, h) + boff + n * 2048 + k * 1024); } while (0)
#define PG8_MMA(ai, bj, At, Bt) do { __builtin_amdgcn_s_setprio(1); _Pragma("unroll") for (int m = 0; m < 4; ++m) _Pragma("unroll") for (int n = 0; n < 2; ++n) \
        mma2<F8>(Bt[n][0], Bt[n][1], At[m][0], At[m][1], acc[ai][bj][m][n]); __builtin_amdgcn_s_setprio(0); } while (0)
#define PG8_WAIT_V(n) asm volatile("s_waitcnt vmcnt(" #n ")" ::: "memory")
#define PG8_WAIT_L(n) asm volatile("s_waitcnt lgkmcnt(" #n ")" ::: "memory")
#define PG8_BAR __builtin_amdgcn_s_barrier()
#define PG8_SCHED __builtin_amdgcn_sched_barrier(0)
    Unit cur, nxt; int ui = 0;
    if (!S.next(0, cur)) return;
    f32x4 acc[2][2][4][2];
#pragma unroll
    for (int a = 0; a < 2; ++a)
#pragma unroll
        for (int b = 0; b < 2; ++b)
#pragma unroll
            for (int m = 0; m < 4; ++m)
#pragma unroll
                for (int n = 0; n < 2; ++n) acc[a][b][m][n] = (f32x4){0.f, 0.f, 0.f, 0.f};
    bf16x8 At[4][2], B0[2][2], B1[2][2];
    unsigned vc[2][2], vn[2][2];
    S.a_off(cur, R, C, vc);
    const char* cA = S.a_ptr(cur); const char* cB = S.b_ptr(cur);
    float epre[8]; E.pre(cur, wr, fr, epre);
    PG8_STAGEB(PG8_SB(0, 0), cB); PG8_STAGEB(PG8_SB(0, 1), cB + hstepB); PG8_STAGEA(PG8_SA(0, 0), cA, vc, 0); PG8_STAGEA(PG8_SA(0, 1), cA, vc, 1);
    if (wr == 1) PG8_BAR;
    PG8_WAIT_V(2); PG8_BAR;
    PG8_STAGEB(PG8_SB(1, 0), cB + kstep); PG8_STAGEA(PG8_SA(1, 0), cA + kstep, vc, 0); PG8_STAGEB(PG8_SB(1, 1), cB + hstepB + kstep);
    PG8_WAIT_V(6); PG8_BAR;
    for (;;) {
        const bool has_next = S.next(ui + 1, nxt);
        const char* nA = has_next ? S.a_ptr(nxt) : cA; const char* nB = has_next ? S.b_ptr(nxt) : cB;
        if (Sched::GATHER) { if (has_next) S.a_off(nxt, R, C, vn); else {
#pragma unroll
            for (int h = 0; h < 2; ++h)
#pragma unroll
                for (int i = 0; i < 2; ++i) vn[h][i] = vc[h][i]; } }
#pragma unroll 1
        for (int t = 0; t < nt; t += 2) {
            const bool last = (t == nt - 2);
            const char* a1 = cA + (size_t)(t + 1) * kstep;
            const char* a2 = last ? nA : cA + (size_t)(t + 2) * kstep; const char* b2 = last ? nB : cB + (size_t)(t + 2) * kstep;
            const char* a3 = a2 + kstep; const char* b3 = b2 + kstep;
            unsigned v2[2][2];
#pragma unroll
            for (int h = 0; h < 2; ++h)
#pragma unroll
                for (int i = 0; i < 2; ++i) v2[h][i] = (Sched::GATHER && last) ? vn[h][i] : vc[h][i];
            PG8_LDB(B0, 0, 0); PG8_LDB(B1, 0, 1); PG8_SCHED; PG8_LDA(At, 0, 0); PG8_STAGEA(PG8_SA(1, 1), a1, vc, 1);
            PG8_WAIT_V(8); PG8_WAIT_L(0); PG8_BAR; PG8_MMA(0, 0, At, B0); PG8_MMA(0, 1, At, B1); PG8_BAR; PG8_SCHED;
            PG8_LDA(At, 0, 1); PG8_STAGEB(PG8_SB(0, 0), b2); PG8_STAGEB(PG8_SB(0, 1), b2 + hstepB); PG8_STAGEA(PG8_SA(0, 0), a2, v2, 0);
            PG8_WAIT_V(8); PG8_WAIT_L(0); PG8_BAR; PG8_MMA(1, 0, At, B0); PG8_MMA(1, 1, At, B1); PG8_BAR; PG8_SCHED;
            PG8_LDB(B0, 1, 0); PG8_LDB(B1, 1, 1); PG8_SCHED; PG8_LDA(At, 1, 0); PG8_STAGEA(PG8_SA(0, 1), a2, v2, 1);
            PG8_WAIT_V(8); PG8_WAIT_L(0); PG8_BAR; PG8_MMA(0, 0, At, B0); PG8_MMA(0, 1, At, B1); PG8_BAR; PG8_SCHED;
            PG8_LDA(At, 1, 1); PG8_STAGEB(PG8_SB(1, 0), b3); PG8_STAGEB(PG8_SB(1, 1), b3 + hstepB); PG8_STAGEA(PG8_SA(1, 0), a3, v2, 0);
            PG8_WAIT_V(8); PG8_WAIT_L(0); PG8_BAR; PG8_MMA(1, 0, At, B0); PG8_MMA(1, 1, At, B1); PG8_BAR; PG8_SCHED;
        }
        if (wr == 0) PG8_BAR;
        if (F8) asm volatile("s_nop 15\n\ts_nop 15" ::: "memory");
        E(acc, cur, wr, wc, fr, fq, epre);
        if (!has_next) break;
#pragma unroll
        for (int a = 0; a < 2; ++a)
#pragma unroll
            for (int b = 0; b < 2; ++b)
#pragma unroll
                for (int m = 0; m < 4; ++m)
#pragma unroll
                    for (int n = 0; n < 2; ++n) acc[a][b][m][n] = (f32x4){0.f, 0.f, 0.f, 0.f};
        cur = nxt; cA = nA; cB = nB; ++ui;
        E.pre(cur, wr, fr, epre);
        if (Sched::GATHER) {
#pragma unroll
            for (int h = 0; h < 2; ++h)
#pragma unroll
                for (int i = 0; i < 2; ++i) vc[h][i] = vn[h][i]; }
        if (wr == 1) PG8_BAR;
    }
    PG8_WAIT_V(0);
    PG8_BAR;
#undef PG8_SA
#undef PG8_SB
#undef PG8_STAGEA
#undef PG8_STAGEB
#undef PG8_LDA
#undef PG8_LDB
#undef PG8_MMA
#undef PG8_WAIT_V
#undef PG8_WAIT_L
#undef PG8_BAR
#undef PG8_SCHED
}

struct EpiG1 {
    static constexpr bool PERM = true;
    bf16_t* U; const float* rstd; float sc;
    DI void pre(const Unit& u, int wr, int fr, float (&p)[8]) const {
#pragma unroll
        for (int ai = 0; ai < 2; ++ai)
#pragma unroll
            for (int m = 0; m < 4; ++m) p[ai * 4 + m] = rstd[u.pm * BM + wr * 64 + fr + ai * HALF + m * 16];
    }
    DI void operator()(const f32x4 (&acc)[2][2][4][2], const Unit& u, int wr, int wc, int fr, int fq, const float (&p)[8]) const {
        const int row0 = u.pm * BM + wr * 64 + fr;
#pragma unroll
        for (int ai = 0; ai < 2; ++ai)
#pragma unroll
            for (int m = 0; m < 4; ++m) {
                const int row = row0 + ai * HALF + m * 16; const float rs = p[ai * 4 + m] * sc;
                if (u.pn < 8) {
                    bf16_t* rowp = U + (size_t)row * UW + u.pn * BM + wc * 32 + 8 * fq;
#pragma unroll
                    for (int bj = 0; bj < 2; ++bj) { const f32x4 v0 = acc[ai][bj][m][0] * rs, v1 = acc[ai][bj][m][1] * rs;
                        u32x4 w = {pk2(v0[0], v0[1]), pk2(v0[2], v0[3]), pk2(v1[0], v1[1]), pk2(v1[2], v1[3])};
                        *(u32x4*)(rowp + bj * HALF) = w; }
                } else {
                    bf16_t* rowp = U + (size_t)row * UW + 2048 + (u.pn - 8) * HALF + wc * 32 + 8 * fq;
                    const float c1 = -1.44269504f * rs;
                    f32x4 o[2];
#pragma unroll
                    for (int n = 0; n < 2; ++n) { const f32x4 A = acc[ai][0][m][n] * rs, t = acc[ai][1][m][n] * c1;
                        f32x4 d = {__builtin_amdgcn_exp2f(t[0]), __builtin_amdgcn_exp2f(t[1]), __builtin_amdgcn_exp2f(t[2]), __builtin_amdgcn_exp2f(t[3])}; d = d + 1.0f;
                        const f32x4 r = {__builtin_amdgcn_rcpf(d[0]), __builtin_amdgcn_rcpf(d[1]), __builtin_amdgcn_rcpf(d[2]), __builtin_amdgcn_rcpf(d[3])}; o[n] = A * r; }
                    u32x4 w = {pk2(o[0][0], o[0][1]), pk2(o[0][2], o[0][3]), pk2(o[1][0], o[1][1]), pk2(o[1][2], o[1][3])};
                    *(u32x4*)rowp = w;
                }
            }
    }
};
struct EpiRes {
    static constexpr bool PERM = true;
    bf16_t* xr; float sc;
    DI void pre(const Unit&, int, int, float (&)[8]) const {}
    DI void operator()(const f32x4 (&acc)[2][2][4][2], const Unit& u, int wr, int wc, int fr, int fq, const float (&)[8]) const {
        const int row0 = u.pm * BM + wr * 64 + fr, col0 = u.pn * BM + wc * 32 + 8 * fq;
#pragma unroll
        for (int ai = 0; ai < 2; ++ai) {
            u32x4 rv[4][2];
#pragma unroll
            for (int m = 0; m < 4; ++m)
#pragma unroll
                for (int bj = 0; bj < 2; ++bj) rv[m][bj] = *(const u32x4*)(xr + (size_t)(row0 + ai * HALF + m * 16) * DM + col0 + bj * HALF);
            __builtin_amdgcn_sched_barrier(0);
#pragma unroll
            for (int m = 0; m < 4; ++m) { bf16_t* rowp = xr + (size_t)(row0 + ai * HALF + m * 16) * DM + col0;
#pragma unroll
                for (int bj = 0; bj < 2; ++bj) { const u32x4 r = rv[m][bj]; const f32x4 a0 = acc[ai][bj][m][0] * sc, a1 = acc[ai][bj][m][1] * sc;
                    u32x4 w = {pk2(bflo(r[0]) + a0[0], bfhi(r[0]) + a0[1]), pk2(bflo(r[1]) + a0[2], bfhi(r[1]) + a0[3]), pk2(bflo(r[2]) + a1[0], bfhi(r[2]) + a1[1]), pk2(bflo(r[3]) + a1[2], bfhi(r[3]) + a1[3])};
                    *(u32x4*)(rowp + bj * HALF) = w; } }
        }
    }
};
struct EpiSwiGLU {
    static constexpr bool PERM = true;
    unsigned char* hid; const float* rstdl; LAS const int* cnt;
    DI void pre(const Unit& u, int wr, int fr, float (&p)[8]) const {
        const int ce = cnt[u.e];
#pragma unroll
        for (int ai = 0; ai < 2; ++ai)
#pragma unroll
            for (int m = 0; m < 4; ++m) { int rin = u.lt * BM + ai * HALF + wr * 64 + m * 16 + fr; rin = rin < ce ? rin : ce - 1; p[ai * 4 + m] = rstdl[(size_t)u.e * LCAP + rin]; }
    }
    DI void operator()(const f32x4 (&acc)[2][2][4][2], const Unit& u, int wr, int wc, int fr, int fq, const float (&p)[8]) const {
#pragma unroll
        for (int ai = 0; ai < 2; ++ai)
#pragma unroll
            for (int m = 0; m < 4; ++m) {
                const int rl = ai * HALF + wr * 64 + m * 16 + fr;
                const float rs = p[ai * 4 + m] * (1.0f / (F8_SX * F8_SW1));
                unsigned char* rowp = hid + (size_t)(u.pm * BM + rl) * DEXP + u.pn * HALF + wc * 32 + 8 * fq;
                const float c1 = -1.44269504f * rs, c2 = rs * rs * F8_SH;
                f32x4 o[2];
#pragma unroll
                for (int n = 0; n < 2; ++n) { const f32x4 G = acc[ai][0][m][n], U = acc[ai][1][m][n], t = G * c1, gu = (G * U) * c2;
                    f32x4 d = {__builtin_amdgcn_exp2f(t[0]), __builtin_amdgcn_exp2f(t[1]), __builtin_amdgcn_exp2f(t[2]), __builtin_amdgcn_exp2f(t[3])}; d = d + 1.0f;
                    const f32x4 r = {__builtin_amdgcn_rcpf(d[0]), __builtin_amdgcn_rcpf(d[1]), __builtin_amdgcn_rcpf(d[2]), __builtin_amdgcn_rcpf(d[3])}; o[n] = gu * r; }
                u32x2 w = {pk4f8(o[0][0], o[0][1], o[0][2], o[0][3]), pk4f8(o[1][0], o[1][1], o[1][2], o[1][3])};
                *(u32x2*)rowp = w;
            }
    }
};
struct EpiDown {
    static constexpr bool PERM = true;
    unsigned char* yb; const float* gatel; LAS const int* cnt;
    DI void pre(const Unit& u, int wr, int fr, float (&p)[8]) const {
        const int ce = cnt[u.e];
#pragma unroll
        for (int ai = 0; ai < 2; ++ai)
#pragma unroll
            for (int m = 0; m < 4; ++m) { int rin = u.lt * BM + ai * HALF + wr * 64 + m * 16 + fr; rin = rin < ce ? rin : ce - 1; p[ai * 4 + m] = gatel[(size_t)u.e * LCAP + rin]; }
    }
    DI void operator()(const f32x4 (&acc)[2][2][4][2], const Unit& u, int wr, int wc, int fr, int fq, const float (&p)[8]) const {
#pragma unroll
        for (int ai = 0; ai < 2; ++ai)
#pragma unroll
            for (int m = 0; m < 4; ++m) {
                const int rl = ai * HALF + wr * 64 + m * 16 + fr;
                const float gt = p[ai * 4 + m] * (F8_SY / (F8_SH * F8_SW2));
                unsigned char* rowp = yb + (size_t)(u.pm * BM + rl) * DM + u.pn * BM + wc * 32 + 8 * fq;
#pragma unroll
                for (int bj = 0; bj < 2; ++bj) { const f32x4 v0 = acc[ai][bj][m][0] * gt, v1 = acc[ai][bj][m][1] * gt;
                    u32x2 w = {pk4f8(v0[0], v0[1], v0[2], v0[3]), pk4f8(v1[0], v1[1], v1[2], v1[3])};
                    *(u32x2*)(rowp + bj * HALF) = w; }
            }
    }
};
}

DI void tr_item(const float* W, int ldw, int scol0, int k0, const float* scale, bf16_t* WT, int Kdst, int drow0, LAS float* scr, int lane) {
    f32x4 v[8]; float sc[8];
#pragma unroll
    for (int i = 0; i < 8; ++i) { const int k = k0 + 8 * i + (lane >> 3); v[i] = __builtin_nontemporal_load((const f32x4*)(W + (size_t)k * ldw + scol0 + 4 * (lane & 7))); sc[i] = scale ? scale[k] : 1.f; }
#pragma unroll
    for (int i = 0; i < 8; ++i) { LAS float* p = scr + (8 * i + (lane >> 3)) * 33 + 4 * (lane & 7);
        p[0] = v[i][0] * sc[i]; p[1] = v[i][1] * sc[i]; p[2] = v[i][2] * sc[i]; p[3] = v[i][3] * sc[i]; }
    LDS_WAIT(); asm volatile("" ::: "memory");
#pragma unroll
    for (int j = 0; j < 4; ++j) { const int p = j * 64 + lane, n = p >> 3, c = p & 7; const LAS float* s = scr + (8 * c) * 33 + n;
        u32x4 o = {pk2(s[0 * 33], s[1 * 33]), pk2(s[2 * 33], s[3 * 33]), pk2(s[4 * 33], s[5 * 33]), pk2(s[6 * 33], s[7 * 33])};
        *(u32x4*)(WT + (size_t)(drow0 + n) * Kdst + k0 + 8 * c) = o; }
    LDS_WAIT(); asm volatile("" ::: "memory");
}
DI void tr_item8(const float* W, int ldw, int scol0, int k0, const float* scale, float mul, unsigned char* WT, int Kdst, int drow0, LAS float* scr, int lane) {
    f32x4 v[8]; float sc[8];
#pragma unroll
    for (int i = 0; i < 8; ++i) { const int k = k0 + 8 * i + (lane >> 3); v[i] = __builtin_nontemporal_load((const f32x4*)(W + (size_t)k * ldw + scol0 + 4 * (lane & 7))); sc[i] = (scale ? scale[k] : 1.f) * mul; }
#pragma unroll
    for (int i = 0; i < 8; ++i) { LAS float* p = scr + (8 * i + (lane >> 3)) * 33 + 4 * (lane & 7);
        p[0] = v[i][0] * sc[i]; p[1] = v[i][1] * sc[i]; p[2] = v[i][2] * sc[i]; p[3] = v[i][3] * sc[i]; }
    LDS_WAIT(); asm volatile("" ::: "memory");
#pragma unroll
    for (int j = 0; j < 2; ++j) { const int p = j * 64 + lane, n = p >> 2, c = p & 3; const LAS float* s = scr + (16 * c) * 33 + n;
        u32x4 o = {pk4f8(s[0 * 33], s[1 * 33], s[2 * 33], s[3 * 33]), pk4f8(s[4 * 33], s[5 * 33], s[6 * 33], s[7 * 33]), pk4f8(s[8 * 33], s[9 * 33], s[10 * 33], s[11 * 33]), pk4f8(s[12 * 33], s[13 * 33], s[14 * 33], s[15 * 33])};
        *(u32x4*)(WT + (size_t)(drow0 + n) * Kdst + k0 + 16 * c) = o; }
    LDS_WAIT(); asm volatile("" ::: "memory");
}
DI int pair_row(int c0) { return 256 * (c0 >> 7) + (c0 & 127); }

template <bool SMALL> DI void convert_dense(Frame& F) {
    LAS float* scr = (LAS float*)(F.lds + F.wave * 16384);
    const int gw = F.bid * NWAVES + F.wave, NGW = F.G * NWAVES;
    for (int l = 0; l < 2; ++l) {
        const float* Win = IN_(F, 2) + (size_t)l * DM * CIN; const float* nm = IN_(F, 1) + l * DM;
        bf16_t* WinT = (bf16_t*)(F.ws + WS_WIN) + (size_t)l * 3072 * DM;
        if (!SMALL) {
        for (int it = gw; it < 16 * 64; it += NGW) { const int kb = it >> 6, nb = it & 63; if (G1F8 && l == 1) tr_item8(Win, CIN, 32 * nb, 64 * kb, nm, F8_SWI, (unsigned char*)WinT, DM, 32 * nb, scr, F.lane); else tr_item(Win, CIN, 32 * nb, 64 * kb, nm, WinT, DM, 32 * nb, scr, F.lane); }
        for (int it = gw; it < 16 * 32; it += NGW) { const int kb = it >> 5, nb = it & 31, ab = nb >> 4, c0 = 32 * (nb & 15);
            if (G1F8 && l == 1) tr_item8(Win, CIN, 2056 + 512 * ab + c0, 64 * kb, nm, F8_SWI, (unsigned char*)WinT, DM, 2048 + pair_row(c0) + 128 * ab, scr, F.lane);
            else tr_item(Win, CIN, 2056 + 512 * ab + c0, 64 * kb, nm, WinT, DM, 2048 + pair_row(c0) + 128 * ab, scr, F.lane); }
        const float* Wout = IN_(F, 11) + (size_t)l * DM * DM; bf16_t* WoutT = (bf16_t*)(F.ws + WS_WOUT) + (size_t)l * DM * DM;
        for (int it = gw; it < 16 * 32; it += NGW) { const int kb = it >> 5, nb = it & 31; if (l == G2F8_L) tr_item8(Wout, DM, 32 * nb, 64 * kb, nullptr, F8_SWO, (unsigned char*)WoutT, DM, 32 * nb, scr, F.lane); else tr_item(Wout, DM, 32 * nb, 64 * kb, nullptr, WoutT, DM, 32 * nb, scr, F.lane); }
        } else {
        float* w1 = (float*)(F.ws + WS_WSM1) + (size_t)l * 16 * DM; float* w2 = (float*)(F.ws + WS_WSM2) + (size_t)l * 48 * DM;
        const float* nf = IN_(F, 12) + l * DM; const float* wrg = IN_(F, 13) + (size_t)l * DM * 4; const float* wre = IN_(F, 15) + (size_t)l * DM * 32;
        for (int i = F.bid * NTHR + F.tid; i < 16 * DM; i += F.G * NTHR) { const int n = i >> 10, k = i & 1023; w1[i] = n < 8 ? Win[(size_t)k * CIN + 2048 + n] * nm[k] : 0.f; }
        for (int i = F.bid * NTHR + F.tid; i < 3 * 16 * 2 * 64; i += F.G * NTHR) { const int ln = i & 63, half = (i >> 6) & 1, kb = (i >> 7) & 15, nt = i >> 11;
            const int n = nt * 16 + (ln & 15), k0 = 64 * kb + 16 * (ln >> 4) + 8 * half;
            float wv[8], wl[8];
#pragma unroll
            for (int j = 0; j < 8; ++j) { const int k = k0 + j; const float w = n < 4 ? wrg[k * 4 + n] * nf[k] : (n < 36 ? wre[k * 32 + (n - 4)] * nf[k] : 0.f);
                const float h = bflo(pk2(w, 0.f)); wv[j] = w; wl[j] = w - h; }
            u32x4 hi = {pk2(wv[0], wv[1]), pk2(wv[2], wv[3]), pk2(wv[4], wv[5]), pk2(wv[6], wv[7])}, lo = {pk2(wl[0], wl[1]), pk2(wl[2], wl[3]), pk2(wl[4], wl[5]), pk2(wl[6], wl[7])};
            unsigned char* wb = (unsigned char*)w2;
            *(u32x4*)(wb + (size_t)(((0 * 3 + nt) * 16 + kb) * 2 + half) * 1024 + ln * 16) = hi;
            *(u32x4*)(wb + (size_t)(((1 * 3 + nt) * 16 + kb) * 2 + half) * 1024 + ln * 16) = lo; }
        }
    }
}
DI unsigned char* wgu_ptr(Frame& F, int l) { return l == 0 ? F.ws + WS_WGU : (unsigned char*)F.out; }
DI unsigned char* wdn_ptr(Frame& F, int l) { return l == 0 ? F.ws + WS_WDN : (unsigned char*)F.out + (size_t)NEXP * 1024 * DM; }
constexpr int CONV_ITEMS = NEXP * 768;
DI void convert_item(Frame& F, int l, int it, LAS float* scr) {
    if (it < NEXP * 512) { const int e = it >> 9, r = it & 511, gu = r >> 8, kb = (r >> 4) & 15, nb = r & 15, c0 = 32 * nb;
        const float* W = (gu ? IN_(F, 18) : IN_(F, 17)) + ((size_t)l * NEXP + e) * DM * DEXP;
        tr_item8(W, DEXP, c0, 64 * kb, IN_(F, 12) + l * DM, F8_SW1, wgu_ptr(F, l) + (size_t)e * 1024 * DM, DM, pair_row(c0) + 128 * gu, scr, F.lane); }
    else { it -= NEXP * 512; const int e = it >> 8, r = it & 255, kb = r >> 5, nb = r & 31;
        const float* W = IN_(F, 19) + ((size_t)l * NEXP + e) * DEXP * DM;
        tr_item8(W, DM, 32 * nb, 64 * kb, nullptr, F8_SW2, wdn_ptr(F, l) + (size_t)e * DM * DEXP, DEXP, 32 * nb, scr, F.lane); }
}
DI void convert_experts(Frame& F, int l, int gw, int NGW) {
    LAS float* scr = (LAS float*)(F.lds + F.wave * 16384);
    for (int it = gw; it < CONV_ITEMS; it += NGW) convert_item(F, l, it, scr);
}
DI void convert_queue(Frame& F, unsigned* done) {
    LAS float* scr = (LAS float*)(F.lds + F.wave * 16384);
    LAS unsigned* box = (LAS unsigned*)(F.lds + MISC_OFF + MS_LCNT);
    unsigned* qh = ctl(F) + CW_QHEAD;
    for (;;) {
        __syncthreads();
        if (F.tid == 0) {
            unsigned b = 0xffffffffu;
            if (!(done && __hip_atomic_load(done, __ATOMIC_RELAXED, __HIP_MEMORY_SCOPE_AGENT) >= (unsigned)F.G)) {
                b = __hip_atomic_fetch_add(qh, 8u, __ATOMIC_RELAXED, __HIP_MEMORY_SCOPE_AGENT); if (b >= (unsigned)CONV_ITEMS) b = 0xffffffffu; }
            box[0] = b;
        }
        __syncthreads();
        const unsigned b = box[0];
        if (b == 0xffffffffu) break;
        convert_item(F, 1, (int)b + F.wave, scr);
    }
    __syncthreads();
}

DI void build_seg_tables(Frame& F, int l) {
    LAS int* cnt = misc_i(F, MS_CNT); LAS int* tst = misc_i(F, MS_TST);
    __syncthreads();
    if (F.tid < NEXP) cnt[F.tid] = (int)__hip_atomic_load(ctl(F) + CW_CNT + (l * NEXP + F.tid) * 64, __ATOMIC_RELAXED, __HIP_MEMORY_SCOPE_AGENT);
    __syncthreads();
    if (F.tid == 0) { int a = 0; for (int e = 0; e < NEXP; ++e) { tst[e] = a; a += (cnt[e] + 255) >> 8; } tst[NEXP] = a; }
    __syncthreads();
}

template <int MODE>
DI void norm1_pass(Frame& F, int l) {
    const float* src = IN_(F, 0);
    bf16_t* XB = (bf16_t*)(F.ws + WS_XR); float* rstd = (float*)(F.ws + WS_RSTD);
    float* gbuf = (float*)(F.ws + WS_G); float* bbuf = (float*)(F.ws + WS_BETA);
    const unsigned char* yb = F.ws + WS_RB; const unsigned* tokep = (const unsigned*)(F.ws + WS_TOKEP);
    LAS const int* tst = misc_i(F, MS_TST);
    const int r = F.lane & 15, kq = F.lane >> 4;
    LAS float* wl = (LAS float*)F.lds;
    {
        const float* Win = IN_(F, 2) + (size_t)l * DM * CIN + 2048; const float* nm = IN_(F, 1) + l * DM;
        for (int i = F.tid; i < 8 * DM; i += NTHR) { const int k = i >> 3, n = i & 7; wl[n * 1028 + k] = Win[(size_t)k * CIN + n] * nm[k]; }
        for (int i = F.tid; i < 8 * 1028; i += NTHR) wl[8 * 1028 + i] = 0.f;
        __syncthreads();
    }
    const LAS float* wsm = wl;
    for (int unit = F.bid * NWAVES + F.wave; unit < T_TOK / 16; unit += F.G * NWAVES) {
        const int row0 = unit * 16, row = row0 + r;
        size_t s0 = 0, s1 = 0;
        if (MODE == 2) { const unsigned e0 = tokep[row * 2], e1 = tokep[row * 2 + 1]; s0 = (size_t)tst[e0 >> 16] * 256 + (e0 & 0xffffu); s1 = (size_t)tst[e1 >> 16] * 256 + (e1 & 0xffffu); }
        f32x4 acc = {0.f, 0.f, 0.f, 0.f}; float ss = 0.f;
        constexpr int CK = MODE == 0 ? 4 : 2, NCH = 16 / CK;
        f32x4 xf[2][CK][4]; u32x4 xu[2][CK][2], ya[2][CK], yc[2][CK];
#define N1_LOAD(buf, c) do { _Pragma("unroll") for (int q = 0; q < CK; ++q) { const int kb = CK * (c) + q, k = kb * 64 + kq * 16; \
            if (MODE == 0) { _Pragma("unroll") for (int j = 0; j < 4; ++j) xf[buf][q][j] = __builtin_nontemporal_load((const f32x4*)(src + (size_t)row * DM + kb * 64 + 4 * kq + 16 * j)); } \
            else { xu[buf][q][0] = *(const u32x4*)(XB + (size_t)row * DM + k); xu[buf][q][1] = *(const u32x4*)(XB + (size_t)row * DM + k + 8); } \
            if (MODE == 2) { ya[buf][q] = *(const u32x4*)(yb + s0 * DM + k); yc[buf][q] = *(const u32x4*)(yb + s1 * DM + k); } } } while (0)
        N1_LOAD(0, 0);
#pragma unroll 1
        for (int c2 = 0; c2 < NCH; c2 += 2)
#pragma unroll
        for (int cb = 0; cb < 2; ++cb) {
            const int c = c2 + cb;
            if (cb == 0) N1_LOAD(1, c + 1); else if (c + 1 < NCH) N1_LOAD(0, c + 1);
            __builtin_amdgcn_sched_barrier(0);
#pragma unroll
            for (int q = 0; q < CK; ++q) {
                const int kb = CK * c + q, k = kb * 64 + kq * 16;
                const int kj0 = MODE == 0 ? kb * 64 + 4 * kq : k, kjs = MODE == 0 ? 16 : 4;
                f32x4 xv[4], bv[4];
#pragma unroll
                for (int j = 0; j < 4; ++j) bv[j] = *(const LAS f32x4*)(wsm + r * 1028 + kj0 + kjs * j);
                if (MODE == 0) {
#pragma unroll
                    for (int j = 0; j < 4; ++j) xv[j] = xf[cb][q][j];
                } else {
                    const u32x4 x0 = xu[cb][q][0], x1 = xu[cb][q][1];
#pragma unroll
                    for (int j = 0; j < 2; ++j) {
                        xv[0][2 * j] = bflo(x0[j]); xv[0][2 * j + 1] = bfhi(x0[j]); xv[1][2 * j] = bflo(x0[2 + j]); xv[1][2 * j + 1] = bfhi(x0[2 + j]);
                        xv[2][2 * j] = bflo(x1[j]); xv[2][2 * j + 1] = bfhi(x1[j]); xv[3][2 * j] = bflo(x1[2 + j]); xv[3][2 * j + 1] = bfhi(x1[2 + j]); }
                }
                if (MODE == 2) {
                    const u32x4 a = ya[cb][q], b = yc[cb][q];
#pragma unroll
                    for (int j = 0; j < 4; ++j) xv[j] += (f8x4(a[j]) + f8x4(b[j])) * (1.0f / F8_SY);
                }
#pragma unroll
                for (int j = 0; j < 4; ++j) ss += xv[j][0] * xv[j][0] + xv[j][1] * xv[j][1] + xv[j][2] * xv[j][2] + xv[j][3] * xv[j][3];
                if (MODE == 0) {
#pragma unroll
                    for (int j = 0; j < 4; ++j) { u32x2 o = {pk2(xv[j][0], xv[j][1]), pk2(xv[j][2], xv[j][3])}; *(u32x2*)(XB + (size_t)row * DM + kj0 + kjs * j) = o; }
                } else {
                    u32x4 o0 = {pk2(xv[0][0], xv[0][1]), pk2(xv[0][2], xv[0][3]), pk2(xv[1][0], xv[1][1]), pk2(xv[1][2], xv[1][3])};
                    u32x4 o1 = {pk2(xv[2][0], xv[2][1]), pk2(xv[2][2], xv[2][3]), pk2(xv[3][0], xv[3][1]), pk2(xv[3][2], xv[3][3])};
                    *(u32x4*)(XB + (size_t)row * DM + k) = o0; *(u32x4*)(XB + (size_t)row * DM + k + 8) = o1;
                    if (G1F8 && MODE == 2) { u32x4 o8 = {pk4f8(F8_SX * xv[0][0], F8_SX * xv[0][1], F8_SX * xv[0][2], F8_SX * xv[0][3]), pk4f8(F8_SX * xv[1][0], F8_SX * xv[1][1], F8_SX * xv[1][2], F8_SX * xv[1][3]),
                                                         pk4f8(F8_SX * xv[2][0], F8_SX * xv[2][1], F8_SX * xv[2][2], F8_SX * xv[2][3]), pk4f8(F8_SX * xv[3][0], F8_SX * xv[3][1], F8_SX * xv[3][2], F8_SX * xv[3][3])};
                        *(u32x4*)(F.ws + WS_X8 + (size_t)row * DM + k) = o8; }
                }
#pragma unroll
                for (int j = 0; j < 4; ++j)
#pragma unroll
                    for (int i = 0; i < 4; ++i) acc = __builtin_amdgcn_mfma_f32_16x16x4f32(xv[j][i], bv[j][i], acc, 0, 0, 0);
            }
        }
#undef N1_LOAD
        ss += __shfl_xor(ss, 16); ss += __shfl_xor(ss, 32);
        const float rs = __builtin_amdgcn_rsqf(ss * (1.0f / DM) + EPS);
        if (kq == 0) rstd[row] = rs;
        const int n = r, rq = kq;
#pragma unroll
        for (int i = 0; i < 4; ++i) {
            const float rsi = __shfl(rs, 4 * rq + i); const int rowi = row0 + 4 * rq + i; const float v = acc[i] * rsi;
            if (n < 4) bbuf[rowi * 4 + n] = sigmoidf_(v);
            else if (n < 8) { const float x = v + IN_(F, 5)[l * 4 + (n - 4)]; const float sp = x > 20.f ? x : log1pf(__expf(x)); gbuf[rowi * 4 + (n - 4)] = -__expf(IN_(F, 4)[l * 4 + (n - 4)]) * sp; }
        }
    }
}

DI void norm2_pass(Frame& F, int l) {
    const bf16_t* XB = (const bf16_t*)(F.ws + WS_XR); unsigned char* X8 = F.ws + WS_X8;
    const unsigned char* wb = F.ws + WS_WSM2 + (size_t)l * 48 * DM * 4;
    unsigned* tokep = (unsigned*)(F.ws + WS_TOKEP); unsigned* list = (unsigned*)(F.ws + WS_LIST);
    float* gatel = (float*)(F.ws + WS_GATEL); float* rstdl = (float*)(F.ws + WS_RSTDL);
    LAS int* lcnt = misc_i(F, MS_LCNT); LAS int* gbase = misc_i(F, MS_GBASE);
    LAS unsigned char* wl = F.lds;
    LAS float* lg = (LAS float*)(F.lds + 98304 + F.wave * 3072);
    const int r = F.lane & 15, kq = F.lane >> 4;
    for (int ub = F.bid * NWAVES; ub < T_TOK / 16; ub += F.G * NWAVES) {
        const int unit = ub + F.wave, row0 = unit * 16, row = row0 + r;
        if (F.tid < NEXP) lcnt[F.tid] = 0;
        f32x4 acc[3]; acc[0] = acc[1] = acc[2] = (f32x4){0.f, 0.f, 0.f, 0.f}; float ss = 0.f;
#pragma unroll 1
        for (int hf = 0; hf < 2; ++hf) {
            __syncthreads();
#pragma unroll
            for (int p = 0; p < 12; ++p) { const int piece = p * 8 + F.wave, g6 = piece >> 4, kk = piece & 15;
                *(LAS u32x4*)(wl + piece * 1024 + F.lane * 16) = *(const u32x4*)(wb + (size_t)((g6 * 16 + hf * 8) * 2 + kk) * 1024 + F.lane * 16); }
            __syncthreads();
#pragma unroll 2
            for (int kb8 = 0; kb8 < 8; ++kb8) {
                const int k = (hf * 8 + kb8) * 64 + kq * 16;
                const u32x4 x0 = *(const u32x4*)(XB + (size_t)row * DM + k), x1 = *(const u32x4*)(XB + (size_t)row * DM + k + 8);
#pragma unroll
                for (int j = 0; j < 4; ++j) { const float a = bflo(x0[j]), b = bfhi(x0[j]), c = bflo(x1[j]), d = bfhi(x1[j]); ss += (a * a + b * b) + (c * c + d * d); }
                {
                    u32x4 o8 = {pk4f8(F8_SX * bflo(x0[0]), F8_SX * bfhi(x0[0]), F8_SX * bflo(x0[1]), F8_SX * bfhi(x0[1])), pk4f8(F8_SX * bflo(x0[2]), F8_SX * bfhi(x0[2]), F8_SX * bflo(x0[3]), F8_SX * bfhi(x0[3])),
                                pk4f8(F8_SX * bflo(x1[0]), F8_SX * bfhi(x1[0]), F8_SX * bflo(x1[1]), F8_SX * bfhi(x1[1])), pk4f8(F8_SX * bflo(x1[2]), F8_SX * bfhi(x1[2]), F8_SX * bflo(x1[3]), F8_SX * bfhi(x1[3]))};
                    *(u32x4*)(X8 + (size_t)row * DM + k) = o8; }
                const bf16x8 a0 = __builtin_bit_cast(bf16x8, x0), a1 = __builtin_bit_cast(bf16x8, x1);
#pragma unroll
                for (int nt = 0; nt < 3; ++nt)
#pragma unroll
                    for (int hl = 0; hl < 2; ++hl) {
                        const LAS unsigned char* fp = wl + ((hl * 3 + nt) * 16 + kb8 * 2) * 1024 + F.lane * 16;
                        acc[nt] = MFMA16(a0, *(const LAS bf16x8*)fp, acc[nt]);
                        acc[nt] = MFMA16(a1, *(const LAS bf16x8*)(fp + 1024), acc[nt]);
                    }
            }
        }
        ss += __shfl_xor(ss, 16); ss += __shfl_xor(ss, 32);
        const float rs = __builtin_amdgcn_rsqf(ss * (1.0f / DM) + EPS);
        {
            const int n = r, rq = kq;
#pragma unroll
            for (int i = 0; i < 4; ++i) { const float rsi = __shfl(rs, 4 * rq + i);
#pragma unroll
                for (int nt = 0; nt < 3; ++nt) lg[(4 * rq + i) * 48 + nt * 16 + n] = acc[nt][i] * rsi; }
        }
        LDS_WAIT(); asm volatile("" ::: "memory");
        int e0 = 0, e1 = 0, lp0 = 0, lp1 = 0; float g0 = 0.f, g1 = 0.f;
        if (F.lane < 16) {
            const LAS float* L = lg + F.lane * 48;
            float gl[4]; float gm = -3.0e38f; int gs = 0;
#pragma unroll
            for (int j = 0; j < 4; ++j) { gl[j] = L[j] + IN_(F, 14)[l * 4 + j]; if (gl[j] > gm) { gm = gl[j]; gs = j; } }
            float gz = 0.f;
#pragma unroll
            for (int j = 0; j < 4; ++j) gz += __expf(gl[j] - gm);
            const float pg = 1.0f / gz;
            float el[8];
#pragma unroll
            for (int j = 0; j < 8; ++j) el[j] = L[4 + gs * 8 + j] + IN_(F, 16)[l * 32 + gs * 8 + j];
            float m0 = -3.0e38f; int i0 = 0;
#pragma unroll
            for (int j = 0; j < 8; ++j) if (el[j] > m0) { m0 = el[j]; i0 = j; }
            float m1 = -3.0e38f; int i1 = 0;
#pragma unroll
            for (int j = 0; j < 8; ++j) if (j != i0 && el[j] > m1) { m1 = el[j]; i1 = j; }
            const float p1 = __expf(m1 - m0), den = 1.0f / (1.0f + p1);
            g0 = pg * den; g1 = pg * p1 * den; e0 = gs * 8 + i0; e1 = gs * 8 + i1;
        }
        __syncthreads();
        if (F.lane < 16) { lp0 = atomicAdd((int*)&lcnt[e0], 1); lp1 = atomicAdd((int*)&lcnt[e1], 1); }
        __syncthreads();
        if (F.tid < NEXP) { const int c = lcnt[F.tid]; gbase[F.tid] = c ? (int)atomicAdd(ctl(F) + CW_CNT + (l * NEXP + F.tid) * 64, (unsigned)c) : 0; }
        __syncthreads();
        if (F.lane < 16) {
            const int rowl = row0 + F.lane; const float rsl = __shfl(rs, F.lane);
            const int p0 = gbase[e0] + lp0, p1 = gbase[e1] + lp1;
            list[(size_t)e0 * LCAP + p0] = rowl; gatel[(size_t)e0 * LCAP + p0] = g0; rstdl[(size_t)e0 * LCAP + p0] = rsl;
            list[(size_t)e1 * LCAP + p1] = rowl; gatel[(size_t)e1 * LCAP + p1] = g1; rstdl[(size_t)e1 * LCAP + p1] = rsl;
            tokep[rowl * 2] = ((unsigned)e0 << 16) | (unsigned)p0; tokep[rowl * 2 + 1] = ((unsigned)e1 << 16) | (unsigned)p1;
        }
        __syncthreads();
    }
}

DI void final_pass(Frame& F) {
    const unsigned char* yb = F.ws + WS_RB; const unsigned* tokep = (const unsigned*)(F.ws + WS_TOKEP);
    const bf16_t* xrb = (const bf16_t*)(F.ws + WS_XR);
    LAS const int* tst = misc_i(F, MS_TST); const float* nw = IN_(F, 20);
    f32x4 w[4];
#pragma unroll
    for (int j = 0; j < 4; ++j) w[j] = *(const f32x4*)(nw + 256 * j + 4 * F.lane);
    const int gw = F.bid * NWAVES + F.wave, per = T_TOK / (F.G * NWAVES);
    for (int rb = gw * per; rb < (gw + 1) * per; rb += 4) {
        u32x2 xr[4][4]; unsigned ya[4][4], yc[4][4];
#pragma unroll
        for (int q = 0; q < 4; ++q) {
            const int row = rb + q;
            const unsigned e0 = tokep[row * 2], e1 = tokep[row * 2 + 1];
            const size_t s0 = (size_t)tst[e0 >> 16] * 256 + (e0 & 0xffffu), s1 = (size_t)tst[e1 >> 16] * 256 + (e1 & 0xffffu);
#pragma unroll
            for (int j = 0; j < 4; ++j) { const int k = 256 * j + 4 * F.lane;
                xr[q][j] = *(const u32x2*)(xrb + (size_t)row * DM + k); ya[q][j] = *(const unsigned*)(yb + s0 * DM + k); yc[q][j] = *(const unsigned*)(yb + s1 * DM + k); }
        }
#pragma unroll
        for (int q = 0; q < 4; ++q) {
            f32x4 v[4]; float ss = 0.f;
#pragma unroll
            for (int j = 0; j < 4; ++j) {
                const f32x4 yv = (f8x4(ya[q][j]) + f8x4(yc[q][j])) * (1.0f / F8_SY);
                v[j][0] = bflo(xr[q][j][0]) + yv[0]; v[j][1] = bfhi(xr[q][j][0]) + yv[1]; v[j][2] = bflo(xr[q][j][1]) + yv[2]; v[j][3] = bfhi(xr[q][j][1]) + yv[3];
                ss += v[j][0] * v[j][0] + v[j][1] * v[j][1] + v[j][2] * v[j][2] + v[j][3] * v[j][3];
            }
            const float rs = __builtin_amdgcn_rsqf(wave_sum(ss) * (1.0f / DM) + EPS);
#pragma unroll
            for (int j = 0; j < 4; ++j) __builtin_nontemporal_store(v[j] * rs * w[j], (f32x4*)(F.out + (size_t)(rb + q) * DM + 256 * j + 4 * F.lane));
        }
    }
}

constexpr int RS = 272;
DI void stage_raw(const bf16_t* U, int colbase, int tok0, int n, LAS unsigned char* raw, int lane) {
    u32x4 v[17];
    const bf16_t* src = U + (size_t)(tok0 - 3 + (lane >> 4)) * UW + colbase + 8 * (lane & 15);
#pragma unroll
    for (int i = 0; i < 17; ++i) {
        const int rr = 4 * i + (lane >> 4);
        v[i] = (u32x4){0u, 0u, 0u, 0u};
        if (rr < 67 && n * CHK + rr - 3 >= 0) v[i] = *(const u32x4*)(src + (size_t)(4 * i) * UW);
    }
#pragma unroll
    for (int i = 0; i < 17; ++i) { const int rr = 4 * i + (lane >> 4); if (rr < 67) *(LAS u32x4*)(raw + rr * RS + 16 * (lane & 15)) = v[i]; }
    LDS_WAIT(); asm volatile("" ::: "memory");
}
DI f32x4 conv4(const LAS unsigned char* rp, const LAS float* wp) {
    f32x4 a = {0.f, 0.f, 0.f, 0.f};
#pragma unroll
    for (int tap = 0; tap < 4; ++tap) {
        const f32x4 w = *(const LAS f32x4*)(wp + tap * 128);
        const u32x2 x = *(const LAS u32x2*)(rp + tap * RS);
        a[0] += w[0] * bflo(x[0]); a[1] += w[1] * bfhi(x[0]); a[2] += w[2] * bflo(x[1]); a[3] += w[3] * bfhi(x[1]);
    }
    return silu4(a);
}
template <bool NORM>
DI void conv_to_frags(const LAS unsigned char* rawl, const LAS float* cwl, float post, rsrc_t drs, int v16, int soff0) {
#pragma unroll 1
    for (int rt = 0; rt < 4; ++rt) {
        const LAS unsigned char* rp = rawl + rt * 16 * RS;
        f32x4 a[8]; float ss = 0.f;
#pragma unroll
        for (int g8 = 0; g8 < 8; ++g8) { a[g8] = conv4(rp + 32 * g8, cwl + 16 * g8); ss += (a[g8][0] * a[g8][0] + a[g8][1] * a[g8][1]) + (a[g8][2] * a[g8][2] + a[g8][3] * a[g8][3]); }
        float sc = post;
        if (NORM) { ss += __shfl_xor(ss, 16); ss += __shfl_xor(ss, 32); sc = __builtin_amdgcn_rsqf(ss + EPS) * post; }
#pragma unroll
        for (int kc = 0; kc < 4; ++kc) BST128(pack8(a[2 * kc] * sc, a[2 * kc + 1] * sc), drs, v16, soff0 + (rt * 4 + kc) * 1024);
    }
}
template <bool NORM>
DI void conv_tile(const LAS unsigned char* rp, const LAS float* cwl, float post, bf16x8 (&P)[4]) {
    f32x4 a[8]; float ss = 0.f;
#pragma unroll
    for (int g8 = 0; g8 < 8; ++g8) { a[g8] = conv4(rp + 32 * g8, cwl + 16 * g8); ss += (a[g8][0] * a[g8][0] + a[g8][1] * a[g8][1]) + (a[g8][2] * a[g8][2] + a[g8][3] * a[g8][3]); }
    float sc = post;
    if (NORM) { ss += __shfl_xor(ss, 16); ss += __shfl_xor(ss, 32); sc = __builtin_amdgcn_rsqf(ss + EPS) * post; }
#pragma unroll
    for (int kc = 0; kc < 4; ++kc) P[kc] = pack8(a[2 * kc] * sc, a[2 * kc + 1] * sc);
}
#define BLD128C(rs, voff, soff) __builtin_bit_cast(bf16x8, __builtin_amdgcn_raw_buffer_load_b128((rs), (voff), (soff), 16))
DI void dn_chunk_local(Frame& F, int l, int unit) {
    const int s = unit >> 7, n = unit & 127, b = s >> 2, h = s & 3, tok0 = b * SEQ + n * CHK;
    const int lane = F.lane, r = lane & 15, kq = lane >> 4;
    const bf16_t* U = (const bf16_t*)(F.ws + WS_RB);
    unsigned char* dn = F.ws + WS_RA + (size_t)unit * DN_BYTES;
    const rsrc_t drs = mk_rsrc(dn, DN_BYTES); const int v16 = lane * 16, v8 = lane * 8;
    LAS unsigned char* raw = F.lds + F.wave * C1_WAVE_BYTES;
    LAS float* AT = (LAS float*)raw;
    LAS float* GC = (LAS float*)(F.lds + C1_EXTRA + MS_WAVE + F.wave * 512);
    const LAS float* CW = (const LAS float*)(F.lds + C1_EXTRA + MS_CONVW);
    const LAS unsigned char* rawl = raw + r * RS + 8 * kq;
    {
        float gv = ((const float*)(F.ws + WS_G))[(size_t)(tok0 + lane) * 4 + h];
        const float bt = ((const float*)(F.ws + WS_BETA))[(size_t)(tok0 + lane) * 4 + h];
#pragma unroll
        for (int off = 1; off < 64; off <<= 1) { const float t = __shfl_up(gv, off); if (lane >= off) gv += t; }
        const float glast = __shfl(gv, 63);
        GC[lane] = gv; GC[64 + lane] = bt;
        float* gt = (float*)(dn + DN_G);
        gt[lane] = bt; gt[64 + lane] = __expf(gv); gt[128 + lane] = __expf(glast - gv); gt[192 + lane] = __expf(glast);
    }
    bf16x8 sel0, sel1;
    {
        unsigned w0[2] = {0u, 0u};
        if (kq == (r >> 2)) { const int j = r & 3; w0[j >> 1] = (j & 1) ? 0x3F800000u : 0x00003F80u; }
        sel0 = mk8(w0[0], w0[1], 0u, 0u); sel1 = mk8(0u, 0u, w0[0], w0[1]);
    }
    const f32x4 z4 = {0.f, 0.f, 0.f, 0.f};
    stage_raw(U, 1024 + h * DH, tok0, n, raw, lane);
#pragma unroll 1
    for (int rt = 0; rt < 4; ++rt) {
        bf16x8 P[4]; conv_tile<false>(rawl + rt * 16 * RS, CW + 2 * 512 + 4 * kq, 1.0f, P);
        u32x2 vo[8];
#pragma unroll
        for (int et = 0; et < 8; ++et) { const f32x4 d = MFMA16(P[et >> 1], (et & 1) ? sel1 : sel0, z4); vo[et] = (u32x2){pk2(d[0], d[1]), pk2(d[2], d[3])}; }
#pragma unroll
        for (int et = 0; et < 8; ++et) BST64(vo[et], drs, v8, DN_V + (et * 4 + rt) * 512);
    }
    stage_raw(U, 512 + h * DH, tok0, n, raw, lane);
    bf16x8 kf[4][4];
#pragma unroll
    for (int rt = 0; rt < 4; ++rt) {
        __builtin_amdgcn_sched_barrier(0);
        conv_tile<true>(rawl + rt * 16 * RS, CW + 512 + 4 * kq, 1.0f, kf[rt]);
#pragma unroll
        for (int kc = 0; kc < 4; ++kc) BST128(kf[rt][kc], drs, v16, DN_K + (rt * 4 + kc) * 1024);
        __builtin_amdgcn_sched_barrier(0);
    }
#pragma unroll
    for (int dt = 0; dt < 8; ++dt)
#pragma unroll
        for (int cc = 0; cc < 2; ++cc) {
            const f32x4 d0 = MFMA16(kf[2 * cc][dt >> 1], (dt & 1) ? sel1 : sel0, z4);
            const f32x4 d1 = MFMA16(kf[2 * cc + 1][dt >> 1], (dt & 1) ? sel1 : sel0, z4);
            BST128(pack8(d0, d1), drs, v16, DN_KT + (dt * 2 + cc) * 1024);
        }
    stage_raw(U, h * DH, tok0, n, raw, lane);
#pragma unroll
    for (int ct = 0; ct < 4; ++ct) {
        __builtin_amdgcn_sched_barrier(0);
        bf16x8 qf[4]; conv_tile<true>(rawl + ct * 16 * RS, CW + 4 * kq, 0.08838834764831845f, qf);
#pragma unroll
        for (int kc = 0; kc < 4; ++kc) BST128(qf[kc], drs, v16, DN_Q + (ct * 4 + kc) * 1024);
        const float gcc = GC[16 * ct + r]; const int c = 16 * ct + r;
        f32x4 tl[4];
#pragma unroll
        for (int ctp = 0; ctp < 4; ++ctp) {
            if (ctp <= ct) {
                f32x4 p = z4;
#pragma unroll
                for (int kc = 0; kc < 4; ++kc) p = MFMA16(kf[ctp][kc], qf[kc], p);
                const f32x4 gp = *(const LAS f32x4*)(GC + 16 * ctp + 4 * kq);
#pragma unroll
                for (int i = 0; i < 4; ++i) { const int cp = 16 * ctp + 4 * kq + i; tl[ctp][i] = (c >= cp) ? p[i] * __expf(gcc - gp[i]) : 0.f; }
            } else tl[ctp] = z4;
        }
        BST128(pack8(tl[0], tl[1]), drs, v16, DN_QK + ct * 1024);
        if (ct >= 2) BST128(pack8(tl[2], tl[3]), drs, v16, DN_QK + (2 + ct) * 1024);
    }
#pragma unroll
    for (int jt = 0; jt < 4; ++jt) {
        const f32x4 gj = *(const LAS f32x4*)(GC + 16 * jt + 4 * kq), bj = *(const LAS f32x4*)(GC + 64 + 16 * jt + 4 * kq);
#pragma unroll
        for (int ctp = 0; ctp <= jt; ++ctp) {
            f32x4 g = z4;
#pragma unroll
            for (int kc = 0; kc < 4; ++kc) g = MFMA16(kf[jt][kc], kf[ctp][kc], g);
            const float gcp = GC[16 * ctp + r]; const int cp = 16 * ctp + r;
            f32x4 o;
#pragma unroll
            for (int i = 0; i < 4; ++i) { const int j = 16 * jt + 4 * kq + i; o[i] = (j > cp) ? bj[i] * g[i] * __expf(gj[i] - gcp) : 0.f; }
            *(LAS f32x4*)(AT + cp * 64 + 16 * jt + 4 * kq) = o;
        }
    }
    LDS_WAIT(); asm volatile("" ::: "memory");
    {
        const int blk = lane >> 4, cq = lane & 15;
        float t[16];
#pragma unroll
        for (int c = 0; c < 16; ++c) t[c] = (c == cq) ? 1.f : 0.f;
        const LAS float* ab = AT + (16 * blk) * 64 + 16 * blk;
#pragma unroll
        for (int j = 0; j < 15; ++j)
#pragma unroll
            for (int c4 = (j + 1) >> 2; c4 < 4; ++c4) { const f32x4 a = *(const LAS f32x4*)(ab + j * 64 + 4 * c4);
#pragma unroll
                for (int i = 0; i < 4; ++i) if (4 * c4 + i > j) t[4 * c4 + i] -= a[i] * t[j]; }
        LAS unsigned char* DL = raw + 16384;
        u32x4 d0 = {pk2(t[0], t[1]), pk2(t[2], t[3]), pk2(t[4], t[5]), pk2(t[6], t[7])}, d1 = {pk2(t[8], t[9]), pk2(t[10], t[11]), pk2(t[12], t[13]), pk2(t[14], t[15])};
        *(LAS u32x4*)(DL + lane * 32) = d0; *(LAS u32x4*)(DL + lane * 32 + 16) = d1;
        LDS_WAIT(); asm volatile("" ::: "memory");
        f32x4 Z[4][4];
        f32x4 eye;
#pragma unroll
        for (int i = 0; i < 4; ++i) eye[i] = (4 * kq + i == r) ? 1.f : 0.f;
#pragma unroll
        for (int cb = 3; cb >= 0; --cb) {
            const u32x2 dl = *(const LAS u32x2*)(DL + ((cb * 16 + r) * 16 + 4 * kq) * 2);
            const bf16x8 Df = mk8(dl[0], dl[1], 0u, 0u);
            f32x4 R[4];
#pragma unroll
            for (int nt = 0; nt < 4; ++nt) R[nt] = (nt == cb) ? eye : z4;
#pragma unroll
            for (int t0 = cb + 1; t0 <= 3; t0 += 2) {
                const int t1 = t0 + 1;
                const f32x4 a0 = *(const LAS f32x4*)(AT + (16 * cb + r) * 64 + 16 * t0 + 4 * kq);
                f32x4 a1 = z4; if (t1 <= 3) a1 = *(const LAS f32x4*)(AT + (16 * cb + r) * 64 + 16 * t1 + 4 * kq);
                const bf16x8 Af = pack8(-a0, -a1);
#pragma unroll
                for (int nt = t0; nt < 4; ++nt) R[nt] = MFMA16(Af, pack8(Z[t0][nt], (t1 <= nt) ? Z[t1 <= 3 ? t1 : 3][nt] : z4), R[nt]);
            }
#pragma unroll
            for (int nt = cb; nt < 4; ++nt) Z[cb][nt] = MFMA16(Df, pack8(R[nt], z4), z4);
        }
#pragma unroll
        for (int f = 0; f < 6; ++f) {
            const int rt = f < 4 ? f : f - 2, cc = f < 4 ? 0 : 1;
            const f32x4 lo = (rt >= 2 * cc) ? Z[2 * cc][rt] : z4, hi = (rt >= 2 * cc + 1) ? Z[2 * cc + 1][rt] : z4;
            BST128(pack8(lo, hi), drs, v16, DN_T + f * 1024);
        }
    }
    LDS_WAIT(); asm volatile("" ::: "memory");
}

DI void ring_dma(const unsigned char* blk, LAS unsigned char* buf, int wave, int lane, bool skip_q) {
#pragma unroll
    for (int i = 0; i < 10; ++i) {
        const int c = wave + 8 * i;
        if (c < 77 && !(skip_q && ((c >= 32 && c < 48) || (c >= 54 && c < 60))))
            __builtin_amdgcn_global_load_lds((const unsigned*)(blk + c * 1024 + lane * 16), (LAS unsigned*)(buf + c * 1024), 16, 0, 0);
    }
}
template <int NT, bool OUT>
DI void slice_step(const LAS unsigned char* img, int lane, int rq, int sl, f32x4 (&S)[NT][8], f32x4 (&O)[4]) {
    const f32x4 z4 = {0.f, 0.f, 0.f, 0.f};
    const LAS unsigned char* fl = img + lane * 16;
    const LAS float* gt = (const LAS float*)(img + DN_G);
#define GT_BT(ct) (*(const LAS f32x4*)(gt + 16 * (ct) + 4 * rq))
#define GT_EG(ct) (*(const LAS f32x4*)(gt + 64 + 16 * (ct) + 4 * rq))
#define GT_ED(ct) (*(const LAS f32x4*)(gt + 128 + 16 * (ct) + 4 * rq))
    const float gl = gt[192];
    bf16x8 Sb[NT][4];
#pragma unroll
    for (int t = 0; t < NT; ++t)
#pragma unroll
        for (int kc = 0; kc < 4; ++kc) Sb[t][kc] = pack8(S[t][2 * kc], S[t][2 * kc + 1]);
    f32x4 X[NT][4], O1[4];
#pragma unroll
    for (int ct = 0; ct < 4; ++ct) {
#pragma unroll
        for (int t = 0; t < NT; ++t) X[t][ct] = z4;
        O1[ct] = z4;
#pragma unroll
        for (int kc = 0; kc < 4; ++kc) {
            const bf16x8 a = *(const LAS bf16x8*)(fl + DN_K + (ct * 4 + kc) * 1024);
#pragma unroll
            for (int t = 0; t < NT; ++t) X[t][ct] = MFMA16(a, Sb[t][kc], X[t][ct]);
            if (OUT) O1[ct] = MFMA16(Sb[0][kc], *(const LAS bf16x8*)(fl + DN_Q + (ct * 4 + kc) * 1024), O1[ct]);
        }
    }
    bf16x8 Yb[NT][2];
#pragma unroll
    for (int t = 0; t < NT; ++t) {
        f32x4 Y[4];
#pragma unroll
        for (int ct = 0; ct < 4; ++ct) {
            const f32x4 btc = GT_BT(ct), egc = GT_EG(ct);
            if (t == 0) { const u32x2 vv = *(const LAS u32x2*)(img + DN_V + (sl * 4 + ct) * 512 + lane * 8);
                const f32x4 v = {bflo(vv[0]), bfhi(vv[0]), bflo(vv[1]), bfhi(vv[1])};
                Y[ct] = btc * (v - egc * X[t][ct]); }
            else Y[ct] = -(btc * egc) * X[t][ct];
        }
        Yb[t][0] = pack8(Y[0], Y[1]); Yb[t][1] = pack8(Y[2], Y[3]);
    }
    f32x4 Vn[NT][4];
#pragma unroll
    for (int ct = 0; ct < 4; ++ct) {
        const bf16x8 a0 = *(const LAS bf16x8*)(fl + DN_T + ct * 1024);
#pragma unroll
        for (int t = 0; t < NT; ++t) Vn[t][ct] = MFMA16(a0, Yb[t][0], z4);
        if (ct >= 2) { const bf16x8 a1 = *(const LAS bf16x8*)(fl + DN_T + (2 + ct) * 1024);
#pragma unroll
            for (int t = 0; t < NT; ++t) Vn[t][ct] = MFMA16(a1, Yb[t][1], Vn[t][ct]); }
    }
    if (OUT) {
        const bf16x8 Vnb0 = pack8(Vn[0][0], Vn[0][1]), Vnb1 = pack8(Vn[0][2], Vn[0][3]);
#pragma unroll
        for (int ct = 0; ct < 4; ++ct) { f32x4 o2 = MFMA16(Vnb0, *(const LAS bf16x8*)(fl + DN_QK + ct * 1024), z4);
            if (ct >= 2) o2 = MFMA16(Vnb1, *(const LAS bf16x8*)(fl + DN_QK + (2 + ct) * 1024), o2);
            O[ct] = gt[64 + 16 * ct + (lane & 15)] * O1[ct] + o2; }
    }
    bf16x8 Vsb[NT][2];
#pragma unroll
    for (int t = 0; t < NT; ++t) { Vsb[t][0] = pack8(GT_ED(0) * Vn[t][0], GT_ED(1) * Vn[t][1]); Vsb[t][1] = pack8(GT_ED(2) * Vn[t][2], GT_ED(3) * Vn[t][3]); }
#pragma unroll
    for (int dt = 0; dt < 8; ++dt) {
#pragma unroll
        for (int t = 0; t < NT; ++t) S[t][dt] = S[t][dt] * gl;
#pragma unroll
        for (int cc = 0; cc < 2; ++cc) { const bf16x8 a = *(const LAS bf16x8*)(fl + DN_KT + (dt * 2 + cc) * 1024);
#pragma unroll
            for (int t = 0; t < NT; ++t) S[t][dt] = MFMA16(a, Vsb[t][cc], S[t][dt]); }
    }
#undef GT_BT
#undef GT_EG
#undef GT_ED
}
DI void scan_s1(Frame& F, int u) {
    const int lane = F.lane, n16 = lane & 15, rq = lane >> 4, sl = F.wave;
    const f32x4 z4 = {0.f, 0.f, 0.f, 0.f};
    const unsigned char* blk0 = F.ws + WS_RA + (size_t)(u * 8) * DN_BYTES;
    f32x4 S[2][8], Odummy[4];
#pragma unroll
    for (int dt = 0; dt < 8; ++dt) { S[0][dt] = z4;
#pragma unroll
        for (int i = 0; i < 4; ++i) S[1][dt][i] = (16 * dt + 4 * rq + i == 16 * sl + n16) ? 1.f : 0.f; }
    ring_dma(blk0, F.lds, F.wave, lane, true);
    VM_WAIT(); __builtin_amdgcn_s_barrier();
#pragma unroll 1
    for (int n = 0; n < 8; ++n) {
        if (n + 1 < 8) ring_dma(blk0 + (size_t)(n + 1) * DN_BYTES, F.lds + ((n + 1) & 1) * RING_IMG, F.wave, lane, true);
        slice_step<2, false>(F.lds + (n & 1) * RING_IMG, lane, rq, sl, S, Odummy);
        VM_WAIT(); LDS_WAIT(); __builtin_amdgcn_s_barrier();
    }
    float* qg = (float*)(F.ws + WS_QG) + ((size_t)(u * 8 + sl) * 8) * 256;
#pragma unroll
    for (int dt = 0; dt < 8; ++dt) *(f32x4*)(qg + dt * 256 + lane * 4) = S[0][dt];
    LAS unsigned char* pt = F.lds + F.wave * 4096;
#pragma unroll
    for (int dt = 0; dt < 8; ++dt) { u32x2 o = {pk2(S[1][dt][0], S[1][dt][1]), pk2(S[1][dt][2], S[1][dt][3])}; *(LAS u32x2*)(pt + n16 * 256 + (16 * dt + 4 * rq) * 2) = o; }
    LDS_WAIT(); asm volatile("" ::: "memory");
    unsigned char* pg = F.ws + WS_PG + (size_t)u * 32768;
    const int r = lane & 15, kq = lane >> 4;
#pragma unroll
    for (int dt = 0; dt < 8; ++dt) {
        const LAS unsigned short* p = (const LAS unsigned short*)(pt + (4 * kq) * 256 + (16 * dt + r) * 2);
        u32x2 o = {(unsigned)p[0] | ((unsigned)p[128] << 16), (unsigned)p[256] | ((unsigned)p[384] << 16)};
        *(u32x2*)(pg + (dt * 4 + (sl >> 1)) * 1024 + lane * 16 + (sl & 1) * 8) = o;
    }
    LDS_WAIT(); asm volatile("" ::: "memory");
}
DI void scan_s2(Frame& F, int s) {
    const int lane = F.lane, sl = F.wave;
    const f32x4 z4 = {0.f, 0.f, 0.f, 0.f};
    f32x4 S[8], Q[2][8];
#pragma unroll
    for (int dt = 0; dt < 8; ++dt) S[dt] = z4;
    const unsigned char* pg0 = F.ws + WS_PG + (size_t)(s * 16) * 32768;
    float* qg0 = (float*)(F.ws + WS_QG) + ((size_t)((s * 16) * 8 + sl) * 8) * 256;
#define S2_DMA(g, bufi) do { _Pragma("unroll") for (int i = 0; i < 4; ++i) { const int c = F.wave + 8 * i; \
        __builtin_amdgcn_global_load_lds((const unsigned*)(pg0 + (size_t)(g) * 32768 + c * 1024 + lane * 16), (LAS unsigned*)(F.lds + (bufi) * 32768 + c * 1024), 16, 0, 0); } } while (0)
#define S2_LDQ(g, qi) do { _Pragma("unroll") for (int dt = 0; dt < 8; ++dt) Q[qi][dt] = *(const f32x4*)(qg0 + (size_t)(g) * 16384 + dt * 256 + lane * 4); } while (0)
    S2_LDQ(0, 0); S2_DMA(0, 0); S2_LDQ(1, 1); S2_DMA(1, 1);
    VM_WAIT(); __builtin_amdgcn_s_barrier();
#pragma unroll 1
    for (int g2 = 0; g2 < 16; g2 += 2)
#pragma unroll
    for (int qi = 0; qi < 2; ++qi) {
        const int g = g2 + qi;
        if (g > 0) {
#pragma unroll
            for (int dt = 0; dt < 8; ++dt) *(f32x4*)(qg0 + (size_t)(g - 1) * 16384 + dt * 256 + lane * 4) = S[dt];
        }
        const LAS unsigned char* fl = F.lds + (g & 3) * 32768 + lane * 16;
        bf16x8 Sb[4];
#pragma unroll
        for (int kc = 0; kc < 4; ++kc) Sb[kc] = pack8(S[2 * kc], S[2 * kc + 1]);
#pragma unroll
        for (int dt = 0; dt < 8; ++dt) { f32x4 a = Q[qi][dt];
#pragma unroll
            for (int kc = 0; kc < 4; ++kc) a = MFMA16(*(const LAS bf16x8*)(fl + (dt * 4 + kc) * 1024), Sb[kc], a);
            S[dt] = a; }
        __builtin_amdgcn_sched_barrier(0);
        if (g + 2 < 16) { S2_LDQ(g + 2, qi); S2_DMA(g + 2, (g + 2) & 3); }
        __builtin_amdgcn_sched_barrier(0);
        if (g + 2 < 16) { if (g == 0) asm volatile("s_waitcnt vmcnt(12)" ::: "memory"); else asm volatile("s_waitcnt vmcnt(20)" ::: "memory"); }
        else asm volatile("s_waitcnt vmcnt(8)" ::: "memory");
        __builtin_amdgcn_sched_barrier(0);
        LDS_WAIT(); __builtin_amdgcn_s_barrier();
    }
    VM_WAIT();
#undef S2_DMA
#undef S2_LDQ
}
constexpr int PSUM_OFF = 2 * RING_IMG;
static_assert(PSUM_OFF + 4096 <= MISC_OFF, "LDS map");
DI void scan_s3(Frame& F, int l, int u) {
    const int lane = F.lane, n16 = lane & 15, rq = lane >> 4, sl = F.wave, s = u >> 4, g = u & 15, b = s >> 2, h = s & 3;
    bf16_t* U = (bf16_t*)(F.ws + WS_RB);
    const unsigned char* blk0 = F.ws + WS_RA + (size_t)(u * 8) * DN_BYTES;
    LAS float* psum = (LAS float*)(F.lds + PSUM_OFF);
    const float onw = IN_(F, 6)[l * DH + sl * 16 + n16];
    f32x4 S[1][8], O[4], Op[4]; u32x2 zp[4], zn[4];
    const f32x4 onw4 = *(const f32x4*)(IN_(F, 6) + l * DH + sl * 16 + 4 * rq);
    const float* sst = (const float*)(F.ws + WS_QG) + ((size_t)((u - 1) * 8 + sl) * 8) * 256;
#pragma unroll
    for (int dt = 0; dt < 8; ++dt) S[0][dt] = g > 0 ? *(const f32x4*)(sst + dt * 256 + lane * 4) : (f32x4){0.f, 0.f, 0.f, 0.f};
    ring_dma(blk0, F.lds, F.wave, lane, false);
    VM_WAIT(); __builtin_amdgcn_s_barrier();
#pragma unroll 1
    for (int n = 0; n <= 8; ++n) {
        if (n + 1 < 8) ring_dma(blk0 + (size_t)(n + 1) * DN_BYTES, F.lds + ((n + 1) & 1) * RING_IMG, F.wave, lane, false);
        if (n < 8) {
            const bf16_t* zb = U + (size_t)(b * SEQ + (g * 8 + n) * CHK + n16) * UW + 1536 + h * DH + sl * 16 + 4 * rq;
#pragma unroll
            for (int ct = 0; ct < 4; ++ct) zn[ct] = *(const u32x2*)(zb + (size_t)(16 * ct) * UW);
        }
        __builtin_amdgcn_sched_barrier(0);
        if (n > 0) {
            bf16_t* yb = U + (size_t)(b * SEQ + (g * 8 + n - 1) * CHK + n16) * UW + 512 + h * DH + sl * 16 + 4 * rq;
            const LAS float* ps = psum + ((n - 1) & 1) * 512;
#pragma unroll
            for (int ct = 0; ct < 4; ++ct) {
                float q = ps[16 * ct + n16];
#pragma unroll
                for (int w = 1; w < 8; ++w) q += ps[w * 64 + 16 * ct + n16];
                const float rs = __builtin_amdgcn_rsqf(q * (1.0f / DH) + EPS);
                const f32x4 o = Op[ct] * rs * onw4;
                const float y0 = o[0] * siluf(bflo(zp[ct][0])), y1 = o[1] * siluf(bfhi(zp[ct][0])), y2 = o[2] * siluf(bflo(zp[ct][1])), y3 = o[3] * siluf(bfhi(zp[ct][1]));
                if (l == G2F8_L) *(unsigned*)(F.ws + WS_A8 + (size_t)(b * SEQ + (g * 8 + n - 1) * CHK + n16 + 16 * ct) * DM + h * DH + sl * 16 + 4 * rq) = pk4f8(F8_SA * y0, F8_SA * y1, F8_SA * y2, F8_SA * y3);
                else { u32x2 yv = {pk2(y0, y1), pk2(y2, y3)}; *(u32x2*)(yb + (size_t)(16 * ct) * UW) = yv; }
            }
        }
        __builtin_amdgcn_sched_barrier(0);
        if (n < 8) {
            slice_step<1, true>(F.lds + (n & 1) * RING_IMG, lane, rq, sl, S, O);
            LAS float* pw = psum + (n & 1) * 512 + sl * 64;
#pragma unroll
            for (int ct = 0; ct < 4; ++ct) {
                float q = (O[ct][0] * O[ct][0] + O[ct][1] * O[ct][1]) + (O[ct][2] * O[ct][2] + O[ct][3] * O[ct][3]);
                q += __shfl_xor(q, 16); q += __shfl_xor(q, 32);
                if (rq == 0) pw[16 * ct + n16] = q;
                Op[ct] = O[ct]; zp[ct] = zn[ct];
            }
        }
        VM_WAIT(); LDS_WAIT(); __builtin_amdgcn_s_barrier();
    }
}

DI void conformer_unit(Frame& F, int l, int unit) {
    const int cp = F.tid & 255, fh = F.tid >> 8, tok0 = unit * 64 + fh * 32, tl0 = tok0 & (SEQ - 1), ch = 2 * cp;
    bf16_t* U = (bf16_t*)(F.ws + WS_RB);
    const rsrc_t urs = mk_rsrc(U + (size_t)((unit * 64) & ~(SEQ - 1)) * UW, SEQ * UW * 2);
    const float* wdw = IN_(F, 7) + (size_t)l * 31 * 512;
    LAS float* cb = (LAS float*)F.lds;
    f32x2 w[31];
#pragma unroll
    for (int i = 0; i < 31; ++i) w[i] = *(const f32x2*)(wdw + i * 512 + ch);
    const f32x2 bias = *(const f32x2*)(IN_(F, 8) + l * 512 + ch);
    __syncthreads();
#pragma unroll 1
    for (int p = 0; p < 2; ++p) {
        const int t0 = tok0 + 16 * p, tl = tl0 + 16 * p;
        unsigned xin[46];
#pragma unroll
        for (int i = 0; i < 46; ++i) xin[i] = __builtin_amdgcn_raw_buffer_load_b32(urs, (tl - 30 + i) * (UW * 2) + (2048 + ch) * 2, 0, 0);
#pragma unroll
        for (int j = 0; j < 16; ++j) {
            f32x2 a = bias;
#pragma unroll
            for (int tap = 0; tap < 31; ++tap) { const f32x2 x = {bflo(xin[j + tap]), bfhi(xin[j + tap])}; a += w[tap] * x; }
            *(LAS f32x2*)(cb + (fh * 32 + 16 * p + j) * 512 + ch) = a;
        }
    }
    __syncthreads();
    const float* lg = IN_(F, 9) + l * 512; const float* lb = IN_(F, 10) + l * 512;
    const f32x4 g0 = *(const f32x4*)(lg + 8 * F.lane), g1 = *(const f32x4*)(lg + 8 * F.lane + 4), b0 = *(const f32x4*)(lb + 8 * F.lane), b1 = *(const f32x4*)(lb + 8 * F.lane + 4);
#pragma unroll 2
    for (int jj = 0; jj < 8; ++jj) {
        const int j = F.wave * 8 + jj;
        const f32x4 a = *(const LAS f32x4*)(cb + j * 512 + 8 * F.lane), b = *(const LAS f32x4*)(cb + j * 512 + 8 * F.lane + 4);
        const float mu = wave_sum((a[0] + a[1]) + (a[2] + a[3]) + (b[0] + b[1]) + (b[2] + b[3])) * (1.0f / 512.0f);
        const f32x4 da = a - mu, db = b - mu;
        const float var = wave_sum((da[0] * da[0] + da[1] * da[1]) + (da[2] * da[2] + da[3] * da[3]) + (db[0] * db[0] + db[1] * db[1]) + (db[2] * db[2] + db[3] * db[3])) * (1.0f / 512.0f);
        const float rs = __builtin_amdgcn_rsqf(var + EPS);
        const f32x4 oa = silu4(da * (g0 * rs) + b0), ob = silu4(db * (g1 * rs) + b1);
        const float o[8] = {oa[0], oa[1], oa[2], oa[3], ob[0], ob[1], ob[2], ob[3]};
        if (l == G2F8_L) { u32x2 ov = {pk4f8(F8_SA * o[0], F8_SA * o[1], F8_SA * o[2], F8_SA * o[3]), pk4f8(F8_SA * o[4], F8_SA * o[5], F8_SA * o[6], F8_SA * o[7])};
            *(u32x2*)(F.ws + WS_A8 + (size_t)(unit * 64 + j) * DM + 512 + 8 * F.lane) = ov; }
        else { u32x4 ov = {pk2(o[0], o[1]), pk2(o[2], o[3]), pk2(o[4], o[5]), pk2(o[6], o[7])};
            *(u32x4*)(U + (size_t)(unit * 64 + j) * UW + 1024 + 8 * F.lane) = ov; }
    }
}
#define IN(k) (lo <= (k) && (k) < hi)
#define SEAM(k) do { if (IN(k) && IN((k) + 1)) xcd_barrier(bar); } while (0)
#define PHASE_FRAME() Frame P = F; { int z_ = 0; asm volatile("" : "+s"(z_), "+v"(P.tid), "+v"(P.lane)); P.ws = F.ws + z_; P.out = F.out + z_; }
template <int l> DI void layer_phases(Frame& F, const XcdBarrier& bar, const int lo, const int hi) {
        const int pb = 1 + 9 * l;
        if (IN(pb + 0)) {
            PHASE_FRAME();
            if (l == 0) { norm1_pass<0>(P, 0); __syncthreads(); convert_dense<true>(P); convert_dense<false>(P); }
            else { build_seg_tables(P, 0); norm1_pass<2>(P, 1); }
        }
        SEAM(pb + 0);
        if (IN(pb + 1)) {
            PHASE_FRAME();
            if (G1F8 && l == 1) {
                pg8::DenseSched S; S.init(P.ws + WS_X8, DM / 2, P.ws + WS_WIN + (size_t)l * 3072 * DM * 2, T_TOK, 3072, DM / 2, P.G, P.bid);
                pg8::EpiG1 E{(bf16_t*)(P.ws + WS_RB), (const float*)(P.ws + WS_RSTD), 1.0f / (F8_SX * F8_SWI)};
                pg8::gemm_phase<true>(P.lds, DM / 2, S, E);
            } else {
                pg8::DenseSched S; S.init(P.ws + WS_XR, DM, (const bf16_t*)(P.ws + WS_WIN) + (size_t)l * 3072 * DM, T_TOK, 3072, DM, P.G, P.bid);
                pg8::EpiG1 E{(bf16_t*)(P.ws + WS_RB), (const float*)(P.ws + WS_RSTD), 1.0f};
                pg8::gemm_phase<false>(P.lds, DM, S, E);
            }
        }
        SEAM(pb + 1);
        if (IN(pb + 2)) {
            PHASE_FRAME();
            const int ub = P.bid * NWAVES; if (ub < 16 * NCHUNK) {
                const int hh = (ub >> 7) & 3;
                __syncthreads();
                for (int i = P.tid; i < 3 * 4 * 128; i += NTHR) { const int tz = i >> 9, tap = (i >> 7) & 3, d = i & 127;
                    ((LAS float*)(P.lds + C1_EXTRA + MS_CONVW))[i] = IN_(P, 3)[(size_t)l * 4 * 1536 + tap * 1536 + tz * 512 + hh * DH + d]; }
                __syncthreads();
                dn_chunk_local(P, l, ub + P.wave);
                VM_WAIT(); __syncthreads();
                scan_s1(P, ub >> 3);
            }
        }
        SEAM(pb + 2);
        if (IN(pb + 3)) {
            PHASE_FRAME();
            if (P.bid < 16) { scan_s2(P, P.bid); __syncthreads(); }
            else if (l == 0) convert_experts(P, 0, (P.bid - 16) * NWAVES + P.wave, (P.G - 16) * NWAVES);
            else convert_queue(P, nullptr);
        }
        SEAM(pb + 3);
        if (IN(pb + 4)) {
            PHASE_FRAME();
            if (P.bid < 256) scan_s3(P, l, P.bid);
            for (int unit = P.bid; unit < T_TOK / 64; unit += P.G) conformer_unit(P, l, unit);
        }
        SEAM(pb + 4);
        if (IN(pb + 5)) {
            PHASE_FRAME();
            if (l == G2F8_L) {
                pg8::DenseSched S; S.init(P.ws + WS_A8, DM / 2, P.ws + WS_WOUT + (size_t)l * DM * DM * 2, T_TOK, DM, DM / 2, P.G, P.bid);
                pg8::EpiRes E{(bf16_t*)(P.ws + WS_XR), 1.0f / (F8_SA * F8_SWO)};
                pg8::gemm_phase<true>(P.lds, DM / 2, S, E);
            } else {
                pg8::DenseSched S; S.init(P.ws + WS_RB + 512 * 2, UW, (const bf16_t*)(P.ws + WS_WOUT) + (size_t)l * DM * DM, T_TOK, DM, DM, P.G, P.bid);
                pg8::EpiRes E{(bf16_t*)(P.ws + WS_XR), 1.0f};
                pg8::gemm_phase<false>(P.lds, DM, S, E);
            }
        }
        SEAM(pb + 5);
        if (IN(pb + 6)) { PHASE_FRAME(); norm2_pass(P, l); }
        SEAM(pb + 6);
        if (IN(pb + 7)) {
            PHASE_FRAME();
            build_seg_tables(P, l);
            pg8::GroupSched<true> S; S.A = (const char*)(P.ws + WS_X8); S.Bt = (const char*)wgu_ptr(P, l); S.list = (const unsigned*)(P.ws + WS_LIST);
            S.tst = misc_i(P, MS_TST); S.cnt = misc_i(P, MS_CNT); S.K = DM / 2; S.ntile = S.tst[NEXP]; S.G = P.G; S.c = P.bid;
            pg8::EpiSwiGLU E{P.ws + WS_HID, (const float*)(P.ws + WS_RSTDL), misc_i(P, MS_CNT)};
            pg8::gemm_phase<true>(P.lds, DM / 2, S, E);
            if (l == 0) { __syncthreads(); unsigned* dn_ = ctl(P) + CW_DONE; if (P.tid == 0) __hip_atomic_fetch_add(dn_, 1u, __ATOMIC_RELAXED, __HIP_MEMORY_SCOPE_AGENT); convert_queue(P, dn_); }
        }
        SEAM(pb + 7);
        if (IN(pb + 8)) {
            PHASE_FRAME();
            build_seg_tables(P, l);
            pg8::GroupSched<false> S; S.A = (const char*)(P.ws + WS_HID); S.Bt = (const char*)wdn_ptr(P, l); S.list = nullptr;
            S.tst = misc_i(P, MS_TST); S.cnt = misc_i(P, MS_CNT); S.K = DEXP / 2; S.ntile = S.tst[NEXP]; S.G = P.G; S.c = P.bid;
            pg8::EpiDown E{P.ws + WS_RB, (const float*)(P.ws + WS_GATEL), misc_i(P, MS_CNT)};
            pg8::gemm_phase<true>(P.lds, DEXP / 2, S, E);
            if (l == 0) { __syncthreads(); unsigned* dn_ = ctl(P) + CW_DONE + 64; if (P.tid == 0) __hip_atomic_fetch_add(dn_, 1u, __ATOMIC_RELAXED, __HIP_MEMORY_SCOPE_AGENT); convert_queue(P, dn_); }
        }
        SEAM(pb + 8);
}

constexpr int NPHASE = 20;

__global__ void __launch_bounds__(NTHR, 2) mk_fwd(const float* __restrict__ i0, const float* __restrict__ i1, const float* __restrict__ i2, const float* __restrict__ i3, const float* __restrict__ i4, const float* __restrict__ i5, const float* __restrict__ i6, const float* __restrict__ i7, const float* __restrict__ i8, const float* __restrict__ i9, const float* __restrict__ i10, const float* __restrict__ i11, const float* __restrict__ i12, const float* __restrict__ i13, const float* __restrict__ i14, const float* __restrict__ i15, const float* __restrict__ i16, const float* __restrict__ i17, const float* __restrict__ i18, const float* __restrict__ i19, const float* __restrict__ i20, float* out_, unsigned char* ws_, int ph_lo, int ph_hi) {
    extern __shared__ __attribute__((aligned(16))) unsigned char lds_raw[];
    Frame F;
    F.lds = (LAS unsigned char*)lds_raw;
    F.tid = threadIdx.x; F.lane = F.tid & 63; F.wave = __builtin_amdgcn_readfirstlane(F.tid >> 6);
    F.G = gridDim.x; F.bid = blockIdx.x;
    F.in[0] = i0; F.in[1] = i1; F.in[2] = i2; F.in[3] = i3; F.in[4] = i4; F.in[5] = i5; F.in[6] = i6; F.in[7] = i7; F.in[8] = i8; F.in[9] = i9; F.in[10] = i10; F.in[11] = i11; F.in[12] = i12; F.in[13] = i13; F.in[14] = i14; F.in[15] = i15; F.in[16] = i16; F.in[17] = i17; F.in[18] = i18; F.in[19] = i19; F.in[20] = i20;
    F.out = out_; F.ws = ws_;
    if (F.tid < 4) ((LAS unsigned*)(F.lds + MISC_OFF + MS_BAR))[F.tid] = 0u;
    __syncthreads();
    XcdBarrier bar; bar.bar = ctl(F) + CW_BAR; bar.x = 0; bar.st = nullptr;
    if (!MK_PER_PHASE) bar = xcd_barrier_post(ctl(F) + CW_BAR, (volatile LAS unsigned*)(F.lds + MISC_OFF + MS_BAR));
    const int lo = ph_lo, hi = ph_hi;
#define IN(k) (lo <= (k) && (k) < hi)
#define SEAM(k) do { if (IN(k) && IN((k) + 1)) xcd_barrier(bar); } while (0)
#define PHASE_FRAME() Frame P = F; { int z_ = 0; asm volatile("" : "+s"(z_), "+v"(P.tid), "+v"(P.lane)); P.ws = F.ws + z_; P.out = F.out + z_; }

    layer_phases<0>(F, bar, lo, hi);
    layer_phases<1>(F, bar, lo, hi);
    if (IN(19)) { PHASE_FRAME(); build_seg_tables(P, 1); final_pass(P); }
#undef IN
#undef SEAM
}

extern "C" void kernel_launch(void* const* d_in, const int* in_sizes, int n_in, void* d_out, int out_size, void* d_ws, size_t ws_size, hipStream_t stream) {
    static int grid = 0;
    if (grid == 0) {
        if (n_in != 21 || ws_size < WS_END) { fprintf(stderr, "kernel_launch: unexpected inputs (n_in %d, ws %zu < %zu)\n", n_in, ws_size, (size_t)WS_END); grid = -1; return; }
        int dev = 0, cus = 0, per_cu = 0;
        if (hipGetDevice(&dev) != hipSuccess || hipDeviceGetAttribute(&cus, hipDeviceAttributeMultiprocessorCount, dev) != hipSuccess) { grid = -1; return; }
        if (hipFuncSetAttribute((const void*)mk_fwd, hipFuncAttributeMaxDynamicSharedMemorySize, LDS_BYTES) != hipSuccess) { grid = -1; return; }
        (void)hipOccupancyMaxActiveBlocksPerMultiprocessor(&per_cu, (const void*)mk_fwd, NTHR, LDS_BYTES);
        (void)hipGetLastError();
        grid = cus;
        if (grid < 256) { fprintf(stderr, "kernel_launch: needs >= 256 CUs (one DeltaNet segment per workgroup)\n"); grid = -1; return; }
        if (grid > 256) grid = 256;
    }
    if (grid < 0) return;
    (void)hipMemsetAsync((char*)d_ws + WS_CTL, 0, CTL_BYTES, stream);
    float* o_ = (float*)d_out; unsigned char* w_ = (unsigned char*)d_ws;
#if MK_PER_PHASE
    for (int p = 0; p < NPHASE; ++p) hipLaunchKernelGGL(mk_fwd, dim3(grid), dim3(NTHR), LDS_BYTES, stream, (const float*)d_in[0], (const float*)d_in[1], (const float*)d_in[2], (const float*)d_in[3], (const float*)d_in[4], (const float*)d_in[5], (const float*)d_in[6], (const float*)d_in[7], (const float*)d_in[8], (const float*)d_in[9], (const float*)d_in[10], (const float*)d_in[11], (const float*)d_in[12], (const float*)d_in[13], (const float*)d_in[14], (const float*)d_in[15], (const float*)d_in[16], (const float*)d_in[17], (const float*)d_in[18], (const float*)d_in[19], (const float*)d_in[20], o_, w_, p, p + 1);
#else
    hipLaunchKernelGGL(mk_fwd, dim3(grid), dim3(NTHR), LDS_BYTES, stream, (const float*)d_in[0], (const float*)d_in[1], (const float*)d_in[2], (const float*)d_in[3], (const float*)d_in[4], (const float*)d_in[5], (const float*)d_in[6], (const float*)d_in[7], (const float*)d_in[8], (const float*)d_in[9], (const float*)d_in[10], (const float*)d_in[11], (const float*)d_in[12], (const float*)d_in[13], (const float*)d_in[14], (const float*)d_in[15], (const float*)d_in[16], (const float*)d_in[17], (const float*)d_in[18], (const float*)d_in[19], (const float*)d_in[20], o_, w_, 0, NPHASE);
#endif
}
```

```cpp
#include <hip/hip_runtime.h>
#include <cstdio>
#include <cstdint>

#ifndef MK_PER_PHASE
#define MK_PER_PHASE 0
#endif

#define LAS __attribute__((address_space(3)))
#define GAS __attribute__((address_space(1)))
typedef unsigned short bf16_t;
typedef short bf16x8 __attribute__((ext_vector_type(8)));
typedef float f32x4 __attribute__((ext_vector_type(4)));
typedef float f32x2 __attribute__((ext_vector_type(2)));
typedef unsigned u32x4 __attribute__((ext_vector_type(4)));
typedef unsigned u32x2 __attribute__((ext_vector_type(2)));
typedef int i32x4 __attribute__((ext_vector_type(4)));
typedef int i32x8 __attribute__((ext_vector_type(8)));
typedef __bf16 bf16x2_t __attribute__((ext_vector_type(2)));
#define DI __device__ __forceinline__

constexpr int T_TOK = 32768, DM = 1024, SEQ = 8192, NHEAD = 4, DH = 128, CHK = 64, NCHUNK = 128;
constexpr int CIN = 3080, UW = 2560;
constexpr int NEXP = 32, DEXP = 512, LCAP = 32768;
constexpr float EPS = 1e-6f;
constexpr int NWAVES = 8, NTHR = 512;

constexpr size_t MiB = 1u << 20;
constexpr size_t WS_CTL = 0, CTL_BYTES = 64 * 1024;
constexpr size_t WS_WSM1 = 1 * MiB;
constexpr size_t WS_WSM2 = 1 * MiB + 128 * 1024;
constexpr size_t WS_RSTD = 2 * MiB;
constexpr size_t WS_G = 2 * MiB + 256 * 1024;
constexpr size_t WS_BETA = 3 * MiB;
constexpr size_t WS_TOKEP = 3 * MiB + 512 * 1024;
constexpr size_t WS_PSQ = 4 * MiB;
constexpr size_t WS_LIST = 8 * MiB;
constexpr size_t WS_GATEL = 12 * MiB;
constexpr size_t WS_RSTDL = 16 * MiB;
constexpr size_t WS_WIN = 20 * MiB;
constexpr size_t WS_WOUT = 32 * MiB;
constexpr size_t WS_WGU = 36 * MiB;
constexpr size_t WS_WDN = 100 * MiB;
constexpr size_t WS_RA = 132 * MiB;
constexpr size_t WS_X8 = WS_RA;
constexpr size_t WS_A8 = 68 * MiB;
constexpr size_t WS_HID = WS_RA + 64 * MiB;
constexpr size_t WS_RB = 288 * MiB;
constexpr size_t WS_PG = 448 * MiB;
constexpr size_t WS_QG = 456 * MiB;
constexpr size_t WS_XR = 472 * MiB;
constexpr size_t WS_END = 536 * MiB;
constexpr int DN_K = 0, DN_KT = 16384, DN_Q = 32768, DN_T = 49152, DN_QK = 55296, DN_V = 61440, DN_G = 77824, DN_BYTES = 78848;
constexpr int CW_BAR = 0, CW_CNT = 4096;
constexpr int CW_QHEAD = 8192 + 64, CW_DONE = 8192 + 128;

constexpr int STAGE_BYTES = 131072;
constexpr int C1_WAVE_BYTES = 18432;
constexpr int C1_EXTRA = 8 * C1_WAVE_BYTES;
constexpr int LDS_BYTES = 163840;
constexpr int MISC_OFF = LDS_BYTES - 2048;
constexpr int MS_BAR = 0;
constexpr int MS_CNT = 64;
constexpr int MS_TST = 256;
constexpr int MS_LCNT = 512;
constexpr int MS_GBASE = 768;
constexpr int MS_WAVE = 0;
constexpr int MS_CONVW = 4096;
constexpr int RING_IMG = 78848;
static_assert(2 * RING_IMG <= MISC_OFF && C1_EXTRA + MS_CONVW + 6144 <= MISC_OFF, "LDS map");

DI unsigned pk2(float a, float b) { f32x2 v = {a, b}; bf16x2_t r = __builtin_convertvector(v, bf16x2_t); return __builtin_bit_cast(unsigned, r); }
DI unsigned pk4f8(float a, float b, float c, float d) {
    a = __builtin_amdgcn_fmed3f(a, -448.f, 448.f); b = __builtin_amdgcn_fmed3f(b, -448.f, 448.f); c = __builtin_amdgcn_fmed3f(c, -448.f, 448.f); d = __builtin_amdgcn_fmed3f(d, -448.f, 448.f);
    int r = __builtin_amdgcn_cvt_pk_fp8_f32(a, b, 0, false); r = __builtin_amdgcn_cvt_pk_fp8_f32(c, d, r, true); return (unsigned)r; }
constexpr float F8_SX = 4.f, F8_SW1 = 64.f, F8_SH = 8.f, F8_SW2 = 32.f, F8_SY = 64.f, F8_SA = 8.f, F8_SWO = 64.f;
constexpr float F8_SWI = 64.f;
constexpr bool G1F8 = true;
constexpr int G2F8_L = 1;
DI f32x4 f8x4(unsigned w) { const f32x2 lo = __builtin_amdgcn_cvt_pk_f32_fp8((int)w, false), hi = __builtin_amdgcn_cvt_pk_f32_fp8((int)w, true); return (f32x4){lo[0], lo[1], hi[0], hi[1]}; }
DI float bflo(unsigned u) { return __builtin_bit_cast(float, u << 16); }
DI float bfhi(unsigned u) { return __builtin_bit_cast(float, u & 0xffff0000u); }
DI float wave_sum(float v) {
#pragma unroll
    for (int o = 1; o < 64; o <<= 1) v += __shfl_xor(v, o);
    return v;
}
template <int N> DI float dpp_ror_(float v) { return __builtin_bit_cast(float, __builtin_amdgcn_update_dpp(0, __builtin_bit_cast(int, v), 0x120 + N, 0xf, 0xf, false)); }
DI float row_sum16(float v) { v += dpp_ror_<8>(v); v += dpp_ror_<4>(v); v += dpp_ror_<2>(v); v += dpp_ror_<1>(v); return v; }
DI float siluf(float x) { return x * __builtin_amdgcn_rcpf(1.0f + __expf(-x)); }
DI float sigmoidf_(float x) { return __builtin_amdgcn_rcpf(1.0f + __expf(-x)); }
DI f32x4 silu4(const f32x4 a) {
    const f32x4 t = a * -1.44269504f;
    f32x4 d = {__builtin_amdgcn_exp2f(t[0]), __builtin_amdgcn_exp2f(t[1]), __builtin_amdgcn_exp2f(t[2]), __builtin_amdgcn_exp2f(t[3])}; d = d + 1.0f;
    const f32x4 r = {__builtin_amdgcn_rcpf(d[0]), __builtin_amdgcn_rcpf(d[1]), __builtin_amdgcn_rcpf(d[2]), __builtin_amdgcn_rcpf(d[3])};
    return a * r; }
#define LDS_WAIT() asm volatile("s_waitcnt lgkmcnt(0)" ::: "memory")
#define VM_WAIT() asm volatile("s_waitcnt vmcnt(0)" ::: "memory")
DI bf16x8 mk8(unsigned a, unsigned b, unsigned c, unsigned d) { u32x4 v = {a, b, c, d}; return __builtin_bit_cast(bf16x8, v); }
DI bf16x8 pack8(const f32x4& lo, const f32x4& hi) { return mk8(pk2(lo[0], lo[1]), pk2(lo[2], lo[3]), pk2(hi[0], hi[1]), pk2(hi[2], hi[3])); }
#define MFMA16(a, b, c) __builtin_amdgcn_mfma_f32_16x16x32_bf16((a), (b), (c), 0, 0, 0)
typedef __amdgpu_buffer_rsrc_t rsrc_t;
DI rsrc_t mk_rsrc(const void* p, unsigned bytes) { return __builtin_amdgcn_make_buffer_rsrc((void*)p, (short)0, (int)bytes, 0x00020000); }
DI rsrc_t mk_rsrc_u(const void* p, unsigned bytes) {
    const uint64_t a = (uint64_t)p; const unsigned lo = __builtin_amdgcn_readfirstlane((unsigned)a), hi = __builtin_amdgcn_readfirstlane((unsigned)(a >> 32));
    return mk_rsrc((const void*)(((uint64_t)hi << 32) | lo), bytes); }
#define BST128(v, rs, voff, soff) __builtin_amdgcn_raw_buffer_store_b128(__builtin_bit_cast(u32x4, (v)), (rs), (voff), (soff), 0)
#define BST64(v, rs, voff, soff) __builtin_amdgcn_raw_buffer_store_b64(__builtin_bit_cast(u32x2, (v)), (rs), (voff), (soff), 0)
#define BLD128(rs, voff, soff) __builtin_bit_cast(bf16x8, __builtin_amdgcn_raw_buffer_load_b128((rs), (voff), (soff), 0))
#define BLD64(rs, voff, soff) __builtin_amdgcn_raw_buffer_load_b64((rs), (voff), (soff), 0)

#define XB_TMO      128
#define XB_XCNT(j)  (256  + 64 * (j))
#define XB_XSUB(j)  (1280 + 64 * (j))
#define XB_XGEN(j)  (2304 + 64 * (j))
#define XB_TOP      3328
#define XB_TOPGEN   3392
#define XCD_BAR_WORDS 3456
#define XB_SPIN_CAP (1u << 18)
DI unsigned xb_ld(unsigned* p)              { return __hip_atomic_load(p, __ATOMIC_RELAXED, __HIP_MEMORY_SCOPE_AGENT); }
DI unsigned xb_add(unsigned* p, unsigned v) { return __hip_atomic_fetch_add(p, v, __ATOMIC_RELAXED, __HIP_MEMORY_SCOPE_AGENT); }
DI unsigned xb_xcc_id() { return (unsigned)__builtin_amdgcn_s_getreg((3 << 11) | 20) & 0xFu; }
#define XB_SPIN(cond, bar) do { unsigned _sp = 0; while (cond) { __builtin_amdgcn_s_sleep(1); \
    if ((++_sp & 255u) == 0u) { if (xb_ld(&(bar)[XB_TMO])) break; if (_sp > XB_SPIN_CAP) { atomicAdd(&(bar)[XB_TMO], 1u); break; } } } } while (0)
struct XcdBarrier { unsigned* bar; unsigned x; volatile LAS unsigned* st; };
DI XcdBarrier xcd_barrier_post(unsigned* bar, volatile LAS unsigned* st) {
    XcdBarrier b; b.bar = bar; b.x = xb_xcc_id(); b.st = st;
    if (threadIdx.x == 0) (void)xb_add(&bar[XB_XCNT(b.x)], 1u);
    return b;
}
DI void xcd_barrier_complete(unsigned* bar, unsigned x, unsigned& nloc, unsigned& nx) {
    const unsigned G = gridDim.x * gridDim.y * gridDim.z;
    unsigned sum, cnt, mine, sp = 0u;
    for (;;) {
        sum = 0u; cnt = 0u; mine = 0u;
#pragma unroll
        for (unsigned j = 0; j < 16; ++j) { const unsigned c = xb_ld(&bar[XB_XCNT(j)]); sum += c; cnt += (c > 0u) ? 1u : 0u; mine = (j == x) ? c : mine; }
        if (sum == G) break;
        __builtin_amdgcn_s_sleep(1);
        if ((++sp & 255u) == 0u) { if (xb_ld(&bar[XB_TMO])) break; if (sp > XB_SPIN_CAP) { atomicAdd(&bar[XB_TMO], 1u); break; } }
    }
    nloc = mine > 0u ? mine : 1u; nx = cnt > 0u ? cnt : 1u;
}
DI void xcd_barrier(const XcdBarrier& b) {
    asm volatile("s_waitcnt vmcnt(0)" ::: "memory");
    __syncthreads();
    if (threadIdx.x == 0) {
        unsigned* bar = b.bar;
        __builtin_amdgcn_s_waitcnt(0);
        unsigned nloc = b.st[0], nx = b.st[1];
        if (nloc == 0u) { xcd_barrier_complete(bar, b.x, nloc, nx); b.st[0] = nloc; b.st[1] = nx; }
        const unsigned old = xb_add(&bar[XB_XSUB(b.x)], 1u);
        const unsigned gen = old / nloc;
        if (old + 1u == (gen + 1u) * nloc) {
            __builtin_amdgcn_fence(__ATOMIC_RELEASE, "agent");
            asm volatile("s_waitcnt vmcnt(0)" ::: "memory");
            const unsigned og = xb_add(&bar[XB_TOP], 1u);
            const unsigned tg = og / nx;
            if (og + 1u == (tg + 1u) * nx) xb_add(&bar[XB_TOPGEN], 1u);
            else XB_SPIN(xb_ld(&bar[XB_TOPGEN]) == tg, bar);
            __builtin_amdgcn_fence(__ATOMIC_ACQUIRE, "agent");
            xb_add(&bar[XB_XGEN(b.x)], 1u);
            asm volatile("s_waitcnt vmcnt(0)" ::: "memory");
        } else {
            XB_SPIN(xb_ld(&bar[XB_XGEN(b.x)]) == gen, bar);
            __builtin_amdgcn_fence(__ATOMIC_ACQUIRE, "agent");
            asm volatile("s_waitcnt vmcnt(0)" ::: "memory");
        }
    }
    __syncthreads();
}

struct Frame {
    LAS unsigned char* lds;
    const float* in[21];
    float* out;
    unsigned char* ws;
    int tid, lane, wave, G, bid;
};
#define IN_(FR, i) ((FR).in[i])
DI LAS int* misc_i(Frame& F, int off) { return (LAS int*)(F.lds + MISC_OFF + off); }
DI unsigned* ctl(Frame& F) { return (unsigned*)(F.ws + WS_CTL); }

namespace pg8 {
constexpr int BM = 256, BK = 64, HALF = 128, HTB = HALF * BK * 2;
DI int lds_byte(int r, int c) { const int st = (r >> 4) * 2 + (c >> 5), rr = r & 15, cc = c & 31, ob = rr * 64 + cc * 2; return st * 1024 + (ob ^ (((ob >> 9) & 1) << 5)); }
DI void stage_rc(int b, int& R, int& C) { const int st = b / 1024, sb = b % 1024, swz = sb ^ (((sb >> 9) & 1) << 5); R = (st >> 1) * 16 + swz / 64; C = (st & 1) * 32 + (swz % 64) / 2; }
DI int perm32(int rho) { const int n = rho >> 4, i = rho & 15; return 8 * (i >> 2) + 4 * n + (i & 3); }
struct Unit { int pm, pn, e, lt; };

struct DenseSched {
    static constexpr bool GATHER = false;
    const char* A; const char* Bt; int lda, K, nM, nN, nwg, G, c;
    DI void init(const void* A_, int lda_, const void* Bt_, int M, int N, int K_, int G_, int c_) { A = (const char*)A_; Bt = (const char*)Bt_; lda = lda_; K = K_; nM = M / BM; nN = N / BM; nwg = nM * nN; G = G_; c = c_; }
    DI bool next(int i, Unit& u) const {
        const long L = (long)i * G + c; if (L >= nwg) return false;
        int wgid = (int)L; { const int q = nwg / 8, r = nwg % 8, xcd = wgid % 8, off = wgid / 8; wgid = (xcd < r ? xcd * (q + 1) : r * (q + 1) + (xcd - r) * q) + off; }
        const int nig = 8 * nN, gid = wgid / nig, fm = gid * 8, gsz = (nM - fm) < 8 ? (nM - fm) : 8;
        u.pm = fm + ((wgid % nig) % gsz); u.pn = (wgid % nig) / gsz; u.e = 0; u.lt = 0; return true;
    }
    DI const char* a_ptr(const Unit& u) const { return A + (size_t)u.pm * BM * lda * 2; }
    DI const char* b_ptr(const Unit& u) const { return Bt + (size_t)u.pn * BM * K * 2; }
    DI void a_off(const Unit&, const int (&R)[2], const int (&C)[2], unsigned (&v)[2][2]) const {
#pragma unroll
        for (int h = 0; h < 2; ++h)
#pragma unroll
            for (int i = 0; i < 2; ++i) v[h][i] = (unsigned)((h * HALF + R[i]) * lda + C[i]) * 2u;
    }
};
template <bool GATHER_> struct GroupSched {
    static constexpr bool GATHER = GATHER_;
    const char* A; const char* Bt; const unsigned* list; LAS const int* tst; LAS const int* cnt; int K, ntile, G, c;
    DI bool next(int i, Unit& u) const {
        int L = i * G + c;
        if (G == 256 && (i + 1) * 256 <= ntile * 4) { const int x = c & 7, j = c >> 3; L = i * 256 + (((x * 8) + (j >> 2)) << 2) + (j & 3); }
        if (L >= ntile * 4) return false;
        const int rt = L >> 2; int e = 0;
#pragma unroll 1
        for (int j = 16; j >= 1; j >>= 1) if (e + j < NEXP && tst[e + j] <= rt) e += j;
        u.pm = rt; u.pn = L & 3; u.e = e; u.lt = rt - tst[e]; return true;
    }
    DI const char* a_ptr(const Unit& u) const { return GATHER ? A : A + (size_t)u.pm * BM * K * 2; }
    DI const char* b_ptr(const Unit& u) const { return Bt + ((size_t)u.e * 1024 + (size_t)u.pn * BM) * K * 2; }
    DI void a_off(const Unit& u, const int (&R)[2], const int (&C)[2], unsigned (&v)[2][2]) const {
        if (GATHER) {
            const int ce = cnt[u.e];
#pragma unroll
            for (int h = 0; h < 2; ++h)
#pragma unroll
                for (int i = 0; i < 2; ++i) { int rin = u.lt * BM + h * HALF + R[i]; rin = rin < ce ? rin : ce - 1; const unsigned tok = list[(size_t)u.e * LCAP + rin]; v[h][i] = (tok * (unsigned)K + (unsigned)C[i]) * 2u; }
        } else {
#pragma unroll
            for (int h = 0; h < 2; ++h)
#pragma unroll
                for (int i = 0; i < 2; ++i) v[h][i] = (unsigned)((h * HALF + R[i]) * K + C[i]) * 2u;
        }
    }
};

template <bool F8> DI void mma2(const bf16x8 b0, const bf16x8 b1, const bf16x8 a0, const bf16x8 a1, f32x4& c) {
    if (F8) { const i32x8 B = __builtin_shufflevector(__builtin_bit_cast(i32x4, b0), __builtin_bit_cast(i32x4, b1), 0, 1, 2, 3, 4, 5, 6, 7), A = __builtin_shufflevector(__builtin_bit_cast(i32x4, a0), __builtin_bit_cast(i32x4, a1), 0, 1, 2, 3, 4, 5, 6, 7);
        asm volatile("v_mfma_f32_16x16x128_f8f6f4 %0, %1, %2, %0" : "+v"(c) : "v"(B), "v"(A)); }
    else { c = __builtin_amdgcn_mfma_f32_16x16x32_bf16(b0, a0, c, 0, 0, 0); c = __builtin_amdgcn_mfma_f32_16x16x32_bf16(b1, a1, c, 0, 0, 0); }
}
template <bool F8, class Epi, class Sched>
DI void gemm_phase(LAS unsigned char* lds, const int K, const Sched& S, const Epi& E) {
    const int tid = threadIdx.x, wid = __builtin_amdgcn_readfirstlane(tid >> 6), lane = tid & 63, wr = wid >> 2, wc = wid & 3, fr = lane & 15, fq = lane >> 4;
    const int nt = K / BK;
    int R[2], C[2]; unsigned voffB[2];
#pragma unroll
    for (int i = 0; i < 2; ++i) { stage_rc(tid * 16 + i * 8192, R[i], C[i]); const int Rb = Epi::PERM ? ((R[i] & ~31) + perm32(R[i] & 31)) : R[i]; voffB[i] = (unsigned)(Rb * K + C[i]) * 2u; }
    const size_t kstep = (size_t)(BK * 2);
    const size_t hstepB = (size_t)HALF * K * 2;
    const unsigned ldsw = (unsigned)wid * 1024u;
    const int aoff = lds_byte(wr * 64 + fr, fq * 8), boff = lds_byte(wc * 32 + fr, fq * 8);
#define PG8_SA(b, h) (((b) * 2 + (h)) * HTB)
#define PG8_SB(b, h) ((4 + (b) * 2 + (h)) * HTB)
#define PG8_STAGEB(bufoff, gbase) do { _Pragma("unroll") for (int _i = 0; _i < 2; ++_i) \
        __builtin_amdgcn_global_load_lds((const unsigned*)((const char*)(gbase) + voffB[_i]), (LAS unsigned*)(lds + (bufoff) + ldsw + _i * 8192), 16, 0, 0); } while (0)
#define PG8_STAGEA(bufoff, gbase, vv, h) do { _Pragma("unroll") for (int _i = 0; _i < 2; ++_i) \
        __builtin_amdgcn_global_load_lds((const unsigned*)((const char*)(gbase) + (vv)[h][_i]), (LAS unsigned*)(lds + (bufoff) + ldsw + _i * 8192), 16, 0, 0); } while (0)
#define PG8_LDA(dst, b, h) do { _Pragma("unroll") for (int m = 0; m < 4; ++m) _Pragma("unroll") for (int k = 0; k < 2; ++k) dst[m][k] = *(const LAS bf16x8*)(lds + PG8_SA(b, h) + aoff + m * 2048 + k * 1024); } while (0)
#define PG8_LDB(dst, b, h) do { _Pragma("unroll") for (int n = 0; n < 2; ++n) _Pragma("unroll") for (int k = 0; k < 2; ++k) dst[n][k] = *(const LAS bf16x8*)(lds + PG8_SB(b, h) + boff + n * 2048 + k * 1024); } while (0)
#define PG8_MMA(ai, bj, At, Bt) do { __builtin_amdgcn_s_setprio(1); _Pragma("unroll") for (int m = 0; m < 4; ++m) _Pragma("unroll") for (int n = 0; n < 2; ++n) \
        mma2<F8>(Bt[n][0], Bt[n][1], At[m][0], At[m][1], acc[ai][bj][m][n]); __builtin_amdgcn_s_setprio(0); } while (0)
#define PG8_WAIT_V(n) asm volatile("s_waitcnt vmcnt(" #n ")" ::: "memory")
#define PG8_WAIT_L(n) asm volatile("s_waitcnt lgkmcnt(" #n ")" ::: "memory")
#define PG8_BAR __builtin_amdgcn_s_barrier()
#define PG8_SCHED __builtin_amdgcn_sched_barrier(0)
    Unit cur, nxt; int ui = 0;
    if (!S.next(0, cur)) return;
    f32x4 acc[2][2][4][2];
#pragma unroll
    for (int a = 0; a < 2; ++a)
#pragma unroll
        for (int b = 0; b < 2; ++b)
#pragma unroll
            for (int m = 0; m < 4; ++m)
#pragma unroll
                for (int n = 0; n < 2; ++n) acc[a][b][m][n] = (f32x4){0.f, 0.f, 0.f, 0.f};
    bf16x8 At[4][2], B0[2][2], B1[2][2];
    unsigned vc[2][2], vn[2][2];
    S.a_off(cur, R, C, vc);
    const char* cA = S.a_ptr(cur); const char* cB = S.b_ptr(cur);
    float epre[8]; E.pre(cur, wr, fr, epre);
    PG8_STAGEB(PG8_SB(0, 0), cB); PG8_STAGEB(PG8_SB(0, 1), cB + hstepB); PG8_STAGEA(PG8_SA(0, 0), cA, vc, 0); PG8_STAGEA(PG8_SA(0, 1), cA, vc, 1);
    if (wr == 1) PG8_BAR;
    PG8_WAIT_V(2); PG8_BAR;
    PG8_STAGEB(PG8_SB(1, 0), cB + kstep); PG8_STAGEA(PG8_SA(1, 0), cA + kstep, vc, 0); PG8_STAGEB(PG8_SB(1, 1), cB + hstepB + kstep);
    PG8_WAIT_V(6); PG8_BAR;
    for (;;) {
        const bool has_next = S.next(ui + 1, nxt);
        const char* nA = has_next ? S.a_ptr(nxt) : cA; const char* nB = has_next ? S.b_ptr(nxt) : cB;
        if (Sched::GATHER) { if (has_next) S.a_off(nxt, R, C, vn); else {
#pragma unroll
            for (int h = 0; h < 2; ++h)
#pragma unroll
                for (int i = 0; i < 2; ++i) vn[h][i] = vc[h][i]; } }
#pragma unroll 1
        for (int t = 0; t < nt; t += 2) {
            const bool last = (t == nt - 2);
            const char* a1 = cA + (size_t)(t + 1) * kstep;
            const char* a2 = last ? nA : cA + (size_t)(t + 2) * kstep; const char* b2 = last ? nB : cB + (size_t)(t + 2) * kstep;
            const char* a3 = a2 + kstep; const char* b3 = b2 + kstep;
            unsigned v2[2][2];
#pragma unroll
            for (int h = 0; h < 2; ++h)
#pragma unroll
                for (int i = 0; i < 2; ++i) v2[h][i] = (Sched::GATHER && last) ? vn[h][i] : vc[h][i];
            PG8_LDB(B0, 0, 0); PG8_LDB(B1, 0, 1); PG8_SCHED; PG8_LDA(At, 0, 0); PG8_STAGEA(PG8_SA(1, 1), a1, vc, 1);
            PG8_WAIT_V(8); PG8_WAIT_L(0); PG8_BAR; PG8_MMA(0, 0, At, B0); PG8_MMA(0, 1, At, B1); PG8_BAR; PG8_SCHED;
            PG8_LDA(At, 0, 1); PG8_STAGEB(PG8_SB(0, 0), b2); PG8_STAGEB(PG8_SB(0, 1), b2 + hstepB); PG8_STAGEA(PG8_SA(0, 0), a2, v2, 0);
            PG8_WAIT_V(8); PG8_WAIT_L(0); PG8_BAR; PG8_MMA(1, 0, At, B0); PG8_MMA(1, 1, At, B1); PG8_BAR; PG8_SCHED;
            PG8_LDB(B0, 1, 0); PG8_LDB(B1, 1, 1); PG8_SCHED; PG8_LDA(At, 1, 0); PG8_STAGEA(PG8_SA(0, 1), a2, v2, 1);
            PG8_WAIT_V(8); PG8_WAIT_L(0); PG8_BAR; PG8_MMA(0, 0, At, B0); PG8_MMA(0, 1, At, B1); PG8_BAR; PG8_SCHED;
            PG8_LDA(At, 1, 1); PG8_STAGEB(PG8_SB(1, 0), b3); PG8_STAGEB(PG8_SB(1, 1), b3 + hstepB); PG8_STAGEA(PG8_SA(1, 0), a3, v2, 0);
            PG8_WAIT_V(8); PG8_WAIT_L(0); PG8_BAR; PG8_MMA(1, 0, At, B0); PG8_MMA(1, 1, At, B1); PG8_BAR; PG8_SCHED;
        }
        if (wr == 0) PG8_BAR;
        if (F8) asm volatile("s_nop 15\n\ts_nop 15" ::: "memory");
        E(acc, cur, wr, wc, fr, fq, epre);
        if (!has_next) break;
#pragma unroll
        for (int a = 0; a < 2; ++a)
#pragma unroll
            for (int b = 0; b < 2; ++b)
#pragma unroll
                for (int m = 0; m < 4; ++m)
#pragma unroll
                    for (int n = 0; n < 2; ++n) acc[a][b][m][n] = (f32x4){0.f, 0.f, 0.f, 0.f};
        cur = nxt; cA = nA; cB = nB; ++ui;
        E.pre(cur, wr, fr, epre);
        if (Sched::GATHER) {
#pragma unroll
            for (int h = 0; h < 2; ++h)
#pragma unroll
                for (int i = 0; i < 2; ++i) vc[h][i] = vn[h][i]; }
        if (wr == 1) PG8_BAR;
    }
    PG8_WAIT_V(0);
    PG8_BAR;
#undef PG8_SA
#undef PG8_SB
#undef PG8_STAGEA
#undef PG8_STAGEB
#undef PG8_LDA
#undef PG8_LDB
#undef PG8_MMA
#undef PG8_WAIT_V
#undef PG8_WAIT_L
#undef PG8_BAR
#undef PG8_SCHED
}

struct EpiG1 {
    static constexpr bool PERM = true;
    bf16_t* U; const float* rstd; float sc;
    DI void pre(const Unit& u, int wr, int fr, float (&p)[8]) const {
#pragma unroll
        for (int ai = 0; ai < 2; ++ai)
#pragma unroll
            for (int m = 0; m < 4; ++m) p[ai * 4 + m] = rstd[u.pm * BM + wr * 64 + fr + ai * HALF + m * 16];
    }
    DI void operator()(const f32x4 (&acc)[2][2][4][2], const Unit& u, int wr, int wc, int fr, int fq, const float (&p)[8]) const {
        const int row0 = u.pm * BM + wr * 64 + fr;
#pragma unroll
        for (int ai = 0; ai < 2; ++ai)
#pragma unroll
            for (int m = 0; m < 4; ++m) {
                const int row = row0 + ai * HALF + m * 16; const float rs = p[ai * 4 + m] * sc;
                if (u.pn < 8) {
                    bf16_t* rowp = U + (size_t)row * UW + u.pn * BM + wc * 32 + 8 * fq;
#pragma unroll
                    for (int bj = 0; bj < 2; ++bj) { const f32x4 v0 = acc[ai][bj][m][0] * rs, v1 = acc[ai][bj][m][1] * rs;
                        u32x4 w = {pk2(v0[0], v0[1]), pk2(v0[2], v0[3]), pk2(v1[0], v1[1]), pk2(v1[2], v1[3])};
                        *(u32x4*)(rowp + bj * HALF) = w; }
                } else {
                    bf16_t* rowp = U + (size_t)row * UW + 2048 + (u.pn - 8) * HALF + wc * 32 + 8 * fq;
                    const float c1 = -1.44269504f * rs;
                    f32x4 o[2];
#pragma unroll
                    for (int n = 0; n < 2; ++n) { const f32x4 A = acc[ai][0][m][n] * rs, t = acc[ai][1][m][n] * c1;
                        f32x4 d = {__builtin_amdgcn_exp2f(t[0]), __builtin_amdgcn_exp2f(t[1]), __builtin_amdgcn_exp2f(t[2]), __builtin_amdgcn_exp2f(t[3])}; d = d + 1.0f;
                        const f32x4 r = {__builtin_amdgcn_rcpf(d[0]), __builtin_amdgcn_rcpf(d[1]), __builtin_amdgcn_rcpf(d[2]), __builtin_amdgcn_rcpf(d[3])}; o[n] = A * r; }
                    u32x4 w = {pk2(o[0][0], o[0][1]), pk2(o[0][2], o[0][3]), pk2(o[1][0], o[1][1]), pk2(o[1][2], o[1][3])};
                    *(u32x4*)rowp = w;
                }
            }
    }
};
struct EpiRes {
    static constexpr bool PERM = true;
    bf16_t* xr; float sc;
    DI void pre(const Unit&, int, int, float (&)[8]) const {}
    DI void operator()(const f32x4 (&acc)[2][2][4][2], const Unit& u, int wr, int wc, int fr, int fq, const float (&)[8]) const {
        const int row0 = u.pm * BM + wr * 64 + fr, col0 = u.pn * BM + wc * 32 + 8 * fq;
#pragma unroll
        for (int ai = 0; ai < 2; ++ai) {
            u32x4 rv[4][2];
#pragma unroll
            for (int m = 0; m < 4; ++m)
#pragma unroll
                for (int bj = 0; bj < 2; ++bj) rv[m][bj] = *(const u32x4*)(xr + (size_t)(row0 + ai * HALF + m * 16) * DM + col0 + bj * HALF);
            __builtin_amdgcn_sched_barrier(0);
#pragma unroll
            for (int m = 0; m < 4; ++m) { bf16_t* rowp = xr + (size_t)(row0 + ai * HALF + m * 16) * DM + col0;
#pragma unroll
                for (int bj = 0; bj < 2; ++bj) { const u32x4 r = rv[m][bj]; const f32x4 a0 = acc[ai][bj][m][0] * sc, a1 = acc[ai][bj][m][1] * sc;
                    u32x4 w = {pk2(bflo(r[0]) + a0[0], bfhi(r[0]) + a0[1]), pk2(bflo(r[1]) + a0[2], bfhi(r[1]) + a0[3]), pk2(bflo(r[2]) + a1[0], bfhi(r[2]) + a1[1]), pk2(bflo(r[3]) + a1[2], bfhi(r[3]) + a1[3])};
                    *(u32x4*)(rowp + bj * HALF) = w; } }
        }
    }
};
struct EpiSwiGLU {
    static constexpr bool PERM = true;
    unsigned char* hid; const float* rstdl; LAS const int* cnt;
    DI void pre(const Unit& u, int wr, int fr, float (&p)[8]) const {
        const int ce = cnt[u.e];
#pragma unroll
        for (int ai = 0; ai < 2; ++ai)
#pragma unroll
            for (int m = 0; m < 4; ++m) { int rin = u.lt * BM + ai * HALF + wr * 64 + m * 16 + fr; rin = rin < ce ? rin : ce - 1; p[ai * 4 + m] = rstdl[(size_t)u.e * LCAP + rin]; }
    }
    DI void operator()(const f32x4 (&acc)[2][2][4][2], const Unit& u, int wr, int wc, int fr, int fq, const float (&p)[8]) const {
#pragma unroll
        for (int ai = 0; ai < 2; ++ai)
#pragma unroll
            for (int m = 0; m < 4; ++m) {
                const int rl = ai * HALF + wr * 64 + m * 16 + fr;
                const float rs = p[ai * 4 + m] * (1.0f / (F8_SX * F8_SW1));
                unsigned char* rowp = hid + (size_t)(u.pm * BM + rl) * DEXP + u.pn * HALF + wc * 32 + 8 * fq;
                const float c1 = -1.44269504f * rs, c2 = rs * rs * F8_SH;
                f32x4 o[2];
#pragma unroll
                for (int n = 0; n < 2; ++n) { const f32x4 G = acc[ai][0][m][n], U = acc[ai][1][m][n], t = G * c1, gu = (G * U) * c2;
                    f32x4 d = {__builtin_amdgcn_exp2f(t[0]), __builtin_amdgcn_exp2f(t[1]), __builtin_amdgcn_exp2f(t[2]), __builtin_amdgcn_exp2f(t[3])}; d = d + 1.0f;
                    const f32x4 r = {__builtin_amdgcn_rcpf(d[0]), __builtin_amdgcn_rcpf(d[1]), __builtin_amdgcn_rcpf(d[2]), __builtin_amdgcn_rcpf(d[3])}; o[n] = gu * r; }
                u32x2 w = {pk4f8(o[0][0], o[0][1], o[0][2], o[0][3]), pk4f8(o[1][0], o[1][1], o[1][2], o[1][3])};
                *(u32x2*)rowp = w;
            }
    }
};
struct EpiDown {
    static constexpr bool PERM = true;
    unsigned char* yb; const float* gatel; LAS const int* cnt;
    DI void pre(const Unit& u, int wr, int fr, float (&p)[8]) const {
        const int ce = cnt[u.e];
#pragma unroll
        for (int ai = 0; ai < 2; ++ai)
#pragma unroll
            for (int m = 0; m < 4; ++m) { int rin = u.lt * BM + ai * HALF + wr * 64 + m * 16 + fr; rin = rin < ce ? rin : ce - 1; p[ai * 4 + m] = gatel[(size_t)u.e * LCAP + rin]; }
    }
    DI void operator()(const f32x4 (&acc)[2][2][4][2], const Unit& u, int wr, int wc, int fr, int fq, const float (&p)[8]) const {
#pragma unroll
        for (int ai = 0; ai < 2; ++ai)
#pragma unroll
            for (int m = 0; m < 4; ++m) {
                const int rl = ai * HALF + wr * 64 + m * 16 + fr;
                const float gt = p[ai * 4 + m] * (F8_SY / (F8_SH * F8_SW2));
                unsigned char* rowp = yb + (size_t)(u.pm * BM + rl) * DM + u.pn * BM + wc * 32 + 8 * fq;
#pragma unroll
                for (int bj = 0; bj < 2; ++bj) { const f32x4 v0 = acc[ai][bj][m][0] * gt, v1 = acc[ai][bj][m][1] * gt;
                    u32x2 w = {pk4f8(v0[0], v0[1], v0[2], v0[3]), pk4f8(v1[0], v1[1], v1[2], v1[3])};
                    *(u32x2*)(rowp + bj * HALF) = w; }
            }
    }
};
}

DI void tr_item(const float* W, int ldw, int scol0, int k0, const float* scale, bf16_t* WT, int Kdst, int drow0, LAS float* scr, int lane) {
    f32x4 v[8]; float sc[8];
#pragma unroll
    for (int i = 0; i < 8; ++i) { const int k = k0 + 8 * i + (lane >> 3); v[i] = __builtin_nontemporal_load((const f32x4*)(W + (size_t)k * ldw + scol0 + 4 * (lane & 7))); sc[i] = scale ? scale[k] : 1.f; }
#pragma unroll
    for (int i = 0; i < 8; ++i) { LAS float* p = scr + (8 * i + (lane >> 3)) * 33 + 4 * (lane & 7);
        p[0] = v[i][0] * sc[i]; p[1] = v[i][1] * sc[i]; p[2] = v[i][2] * sc[i]; p[3] = v[i][3] * sc[i]; }
    LDS_WAIT(); asm volatile("" ::: "memory");
#pragma unroll
    for (int j = 0; j < 4; ++j) { const int p = j * 64 + lane, n = p >> 3, c = p & 7; const LAS float* s = scr + (8 * c) * 33 + n;
        u32x4 o = {pk2(s[0 * 33], s[1 * 33]), pk2(s[2 * 33], s[3 * 33]), pk2(s[4 * 33], s[5 * 33]), pk2(s[6 * 33], s[7 * 33])};
        *(u32x4*)(WT + (size_t)(drow0 + n) * Kdst + k0 + 8 * c) = o; }
    LDS_WAIT(); asm volatile("" ::: "memory");
}
DI void tr_item8(const float* W, int ldw, int scol0, int k0, const float* scale, float mul, unsigned char* WT, int Kdst, int drow0, LAS float* scr, int lane) {
    f32x4 v[8]; float sc[8];
#pragma unroll
    for (int i = 0; i < 8; ++i) { const int k = k0 + 8 * i + (lane >> 3); v[i] = __builtin_nontemporal_load((const f32x4*)(W + (size_t)k * ldw + scol0 + 4 * (lane & 7))); sc[i] = (scale ? scale[k] : 1.f) * mul; }
#pragma unroll
    for (int i = 0; i < 8; ++i) { LAS float* p = scr + (8 * i + (lane >> 3)) * 33 + 4 * (lane & 7);
        p[0] = v[i][0] * sc[i]; p[1] = v[i][1] * sc[i]; p[2] = v[i][2] * sc[i]; p[3] = v[i][3] * sc[i]; }
    LDS_WAIT(); asm volatile("" ::: "memory");
#pragma unroll
    for (int j = 0; j < 2; ++j) { const int p = j * 64 + lane, n = p >> 2, c = p & 3; const LAS float* s = scr + (16 * c) * 33 + n;
        u32x4 o = {pk4f8(s[0 * 33], s[1 * 33], s[2 * 33], s[3 * 33]), pk4f8(s[4 * 33], s[5 * 33], s[6 * 33], s[7 * 33]), pk4f8(s[8 * 33], s[9 * 33], s[10 * 33], s[11 * 33]), pk4f8(s[12 * 33], s[13 * 33], s[14 * 33], s[15 * 33])};
        *(u32x4*)(WT + (size_t)(drow0 + n) * Kdst + k0 + 16 * c) = o; }
    LDS_WAIT(); asm volatile("" ::: "memory");
}
DI int pair_row(int c0) { return 256 * (c0 >> 7) + (c0 & 127); }

template <bool SMALL> DI void convert_dense(Frame& F) {
    LAS float* scr = (LAS float*)(F.lds + F.wave * 16384);
    const int gw = F.bid * NWAVES + F.wave, NGW = F.G * NWAVES;
    for (int l = 0; l < 2; ++l) {
        const float* Win = IN_(F, 2) + (size_t)l * DM * CIN; const float* nm = IN_(F, 1) + l * DM;
        bf16_t* WinT = (bf16_t*)(F.ws + WS_WIN) + (size_t)l * 3072 * DM;
        if (!SMALL) {
        for (int it = gw; it < 16 * 64; it += NGW) { const int kb = it >> 6, nb = it & 63; if (G1F8 && l == 1) tr_item8(Win, CIN, 32 * nb, 64 * kb, nm, F8_SWI, (unsigned char*)WinT, DM, 32 * nb, scr, F.lane); else tr_item(Win, CIN, 32 * nb, 64 * kb, nm, WinT, DM, 32 * nb, scr, F.lane); }
        for (int it = gw; it < 16 * 32; it += NGW) { const int kb = it >> 5, nb = it & 31, ab = nb >> 4, c0 = 32 * (nb & 15);
            if (G1F8 && l == 1) tr_item8(Win, CIN, 2056 + 512 * ab + c0, 64 * kb, nm, F8_SWI, (unsigned char*)WinT, DM, 2048 + pair_row(c0) + 128 * ab, scr, F.lane);
            else tr_item(Win, CIN, 2056 + 512 * ab + c0, 64 * kb, nm, WinT, DM, 2048 + pair_row(c0) + 128 * ab, scr, F.lane); }
        const float* Wout = IN_(F, 11) + (size_t)l * DM * DM; bf16_t* WoutT = (bf16_t*)(F.ws + WS_WOUT) + (size_t)l * DM * DM;
        for (int it = gw; it < 16 * 32; it += NGW) { const int kb = it >> 5, nb = it & 31; if (l == G2F8_L) tr_item8(Wout, DM, 32 * nb, 64 * kb, nullptr, F8_SWO, (unsigned char*)WoutT, DM, 32 * nb, scr, F.lane); else tr_item(Wout, DM, 32 * nb, 64 * kb, nullptr, WoutT, DM, 32 * nb, scr, F.lane); }
        } else {
        float* w1 = (float*)(F.ws + WS_WSM1) + (size_t)l * 16 * DM; float* w2 = (float*)(F.ws + WS_WSM2) + (size_t)l * 48 * DM;
        const float* nf = IN_(F, 12) + l * DM; const float* wrg = IN_(F, 13) + (size_t)l * DM * 4; const float* wre = IN_(F, 15) + (size_t)l * DM * 32;
        for (int i = F.bid * NTHR + F.tid; i < 16 * DM; i += F.G * NTHR) { const int n = i >> 10, k = i & 1023; w1[i] = n < 8 ? Win[(size_t)k * CIN + 2048 + n] * nm[k] : 0.f; }
        for (int i = F.bid * NTHR + F.tid; i < 3 * 16 * 2 * 64; i += F.G * NTHR) { const int ln = i & 63, half = (i >> 6) & 1, kb = (i >> 7) & 15, nt = i >> 11;
            const int n = nt * 16 + (ln & 15), k0 = 64 * kb + 16 * (ln >> 4) + 8 * half;
            float wv[8], wl[8];
#pragma unroll
            for (int j = 0; j < 8; ++j) { const int k = k0 + j; const float w = n < 4 ? wrg[k * 4 + n] * nf[k] : (n < 36 ? wre[k * 32 + (n - 4)] * nf[k] : 0.f);
                const float h = bflo(pk2(w, 0.f)); wv[j] = w; wl[j] = w - h; }
            u32x4 hi = {pk2(wv[0], wv[1]), pk2(wv[2], wv[3]), pk2(wv[4], wv[5]), pk2(wv[6], wv[7])}, lo = {pk2(wl[0], wl[1]), pk2(wl[2], wl[3]), pk2(wl[4], wl[5]), pk2(wl[6], wl[7])};
            unsigned char* wb = (unsigned char*)w2;
            *(u32x4*)(wb + (size_t)(((0 * 3 + nt) * 16 + kb) * 2 + half) * 1024 + ln * 16) = hi;
            *(u32x4*)(wb + (size_t)(((1 * 3 + nt) * 16 + kb) * 2 + half) * 1024 + ln * 16) = lo; }
        }
    }
}
DI unsigned char* wgu_ptr(Frame& F, int l) { return l == 0 ? F.ws + WS_WGU : (unsigned char*)F.out; }
DI unsigned char* wdn_ptr(Frame& F, int l) { return l == 0 ? F.ws + WS_WDN : (unsigned char*)F.out + (size_t)NEXP * 1024 * DM; }
constexpr int CONV_ITEMS = NEXP * 768;
DI void convert_item(Frame& F, int l, int it, LAS float* scr) {
    if (it < NEXP * 512) { const int e = it >> 9, r = it & 511, gu = r >> 8, kb = (r >> 4) & 15, nb = r & 15, c0 = 32 * nb;
        const float* W = (gu ? IN_(F, 18) : IN_(F, 17)) + ((size_t)l * NEXP + e) * DM * DEXP;
        tr_item8(W, DEXP, c0, 64 * kb, IN_(F, 12) + l * DM, F8_SW1, wgu_ptr(F, l) + (size_t)e * 1024 * DM, DM, pair_row(c0) + 128 * gu, scr, F.lane); }
    else { it -= NEXP * 512; const int e = it >> 8, r = it & 255, kb = r >> 5, nb = r & 31;
        const float* W = IN_(F, 19) + ((size_t)l * NEXP + e) * DEXP * DM;
        tr_item8(W, DM, 32 * nb, 64 * kb, nullptr, F8_SW2, wdn_ptr(F, l) + (size_t)e * DM * DEXP, DEXP, 32 * nb, scr, F.lane); }
}
DI void convert_experts(Frame& F, int l, int gw, int NGW) {
    LAS float* scr = (LAS float*)(F.lds + F.wave * 16384);
    for (int it = gw; it < CONV_ITEMS; it += NGW) convert_item(F, l, it, scr);
}
DI void convert_queue(Frame& F, unsigned* done) {
    LAS float* scr = (LAS float*)(F.lds + F.wave * 16384);
    LAS unsigned* box = (LAS unsigned*)(F.lds + MISC_OFF + MS_LCNT);
    unsigned* qh = ctl(F) + CW_QHEAD;
    for (;;) {
        __syncthreads();
        if (F.tid == 0) {
            unsigned b = 0xffffffffu;
            if (!(done && __hip_atomic_load(done, __ATOMIC_RELAXED, __HIP_MEMORY_SCOPE_AGENT) >= (unsigned)F.G)) {
                b = __hip_atomic_fetch_add(qh, 8u, __ATOMIC_RELAXED, __HIP_MEMORY_SCOPE_AGENT); if (b >= (unsigned)CONV_ITEMS) b = 0xffffffffu; }
            box[0] = b;
        }
        __syncthreads();
        const unsigned b = box[0];
        if (b == 0xffffffffu) break;
        convert_item(F, 1, (int)b + F.wave, scr);
    }
    __syncthreads();
}

DI void build_seg_tables(Frame& F, int l) {
    LAS int* cnt = misc_i(F, MS_CNT); LAS int* tst = misc_i(F, MS_TST);
    __syncthreads();
    if (F.tid < NEXP) cnt[F.tid] = (int)__hip_atomic_load(ctl(F) + CW_CNT + (l * NEXP + F.tid) * 64, __ATOMIC_RELAXED, __HIP_MEMORY_SCOPE_AGENT);
    __syncthreads();
    if (F.tid == 0) { int a = 0; for (int e = 0; e < NEXP; ++e) { tst[e] = a; a += (cnt[e] + 255) >> 8; } tst[NEXP] = a; }
    __syncthreads();
}

template <int MODE>
DI void norm1_pass(Frame& F, int l) {
    const float* src = IN_(F, 0);
    bf16_t* XB = (bf16_t*)(F.ws + WS_XR); float* rstd = (float*)(F.ws + WS_RSTD);
    float* gbuf = (float*)(F.ws + WS_G); float* bbuf = (float*)(F.ws + WS_BETA);
    const unsigned char* yb = F.ws + WS_RB; const unsigned* tokep = (const unsigned*)(F.ws + WS_TOKEP);
    LAS const int* tst = misc_i(F, MS_TST);
    const int r = F.lane & 15, kq = F.lane >> 4;
    LAS float* wl = (LAS float*)F.lds;
    {
        const float* Win = IN_(F, 2) + (size_t)l * DM * CIN + 2048; const float* nm = IN_(F, 1) + l * DM;
        for (int i = F.tid; i < 8 * DM; i += NTHR) { const int k = i >> 3, n = i & 7; wl[n * 1028 + k] = Win[(size_t)k * CIN + n] * nm[k]; }
        for (int i = F.tid; i < 8 * 1028; i += NTHR) wl[8 * 1028 + i] = 0.f;
        __syncthreads();
    }
    const LAS float* wsm = wl;
    for (int unit = F.bid * NWAVES + F.wave; unit < T_TOK / 16; unit += F.G * NWAVES) {
        const int row0 = unit * 16, row = row0 + r;
        size_t s0 = 0, s1 = 0;
        if (MODE == 2) { const unsigned e0 = tokep[row * 2], e1 = tokep[row * 2 + 1]; s0 = (size_t)tst[e0 >> 16] * 256 + (e0 & 0xffffu); s1 = (size_t)tst[e1 >> 16] * 256 + (e1 & 0xffffu); }
        f32x4 acc = {0.f, 0.f, 0.f, 0.f}; float ss = 0.f;
        constexpr int CK = MODE == 0 ? 4 : 2, NCH = 16 / CK;
        f32x4 xf[2][CK][4]; u32x4 xu[2][CK][2], ya[2][CK], yc[2][CK];
#define N1_LOAD(buf, c) do { _Pragma("unroll") for (int q = 0; q < CK; ++q) { const int kb = CK * (c) + q, k = kb * 64 + kq * 16; \
            if (MODE == 0) { _Pragma("unroll") for (int j = 0; j < 4; ++j) xf[buf][q][j] = __builtin_nontemporal_load((const f32x4*)(src + (size_t)row * DM + kb * 64 + 4 * kq + 16 * j)); } \
            else { xu[buf][q][0] = *(const u32x4*)(XB + (size_t)row * DM + k); xu[buf][q][1] = *(const u32x4*)(XB + (size_t)row * DM + k + 8); } \
            if (MODE == 2) { ya[buf][q] = *(const u32x4*)(yb + s0 * DM + k); yc[buf][q] = *(const u32x4*)(yb + s1 * DM + k); } } } while (0)
        N1_LOAD(0, 0);
#pragma unroll 1
        for (int c2 = 0; c2 < NCH; c2 += 2)
#pragma unroll
        for (int cb = 0; cb < 2; ++cb) {
            const int c = c2 + cb;
            if (cb == 0) N1_LOAD(1, c + 1); else if (c + 1 < NCH) N1_LOAD(0, c + 1);
            __builtin_amdgcn_sched_barrier(0);
#pragma unroll
            for (int q = 0; q < CK; ++q) {
                const int kb = CK * c + q, k = kb * 64 + kq * 16;
                const int kj0 = MODE == 0 ? kb * 64 + 4 * kq : k, kjs = MODE == 0 ? 16 : 4;
                f32x4 xv[4], bv[4];
#pragma unroll
                for (int j = 0; j < 4; ++j) bv[j] = *(const LAS f32x4*)(wsm + r * 1028 + kj0 + kjs * j);
                if (MODE == 0) {
#pragma unroll
                    for (int j = 0; j < 4; ++j) xv[j] = xf[cb][q][j];
                } else {
                    const u32x4 x0 = xu[cb][q][0], x1 = xu[cb][q][1];
#pragma unroll
                    for (int j = 0; j < 2; ++j) {
                        xv[0][2 * j] = bflo(x0[j]); xv[0][2 * j + 1] = bfhi(x0[j]); xv[1][2 * j] = bflo(x0[2 + j]); xv[1][2 * j + 1] = bfhi(x0[2 + j]);
                        xv[2][2 * j] = bflo(x1[j]); xv[2][2 * j + 1] = bfhi(x1[j]); xv[3][2 * j] = bflo(x1[2 + j]); xv[3][2 * j + 1] = bfhi(x1[2 + j]); }
                }
                if (MODE == 2) {
                    const u32x4 a = ya[cb][q], b = yc[cb][q];
#pragma unroll
                    for (int j = 0; j < 4; ++j) xv[j] += (f8x4(a[j]) + f8x4(b[j])) * (1.0f / F8_SY);
                }
#pragma unroll
                for (int j = 0; j < 4; ++j) ss += xv[j][0] * xv[j][0] + xv[j][1] * xv[j][1] + xv[j][2] * xv[j][2] + xv[j][3] * xv[j][3];
                if (MODE == 0) {
#pragma unroll
                    for (int j = 0; j < 4; ++j) { u32x2 o = {pk2(xv[j][0], xv[j][1]), pk2(xv[j][2], xv[j][3])}; *(u32x2*)(XB + (size_t)row * DM + kj0 + kjs * j) = o; }
                } else {
                    u32x4 o0 = {pk2(xv[0][0], xv[0][1]), pk2(xv[0][2], xv[0][3]), pk2(xv[1][0], xv[1][1]), pk2(xv[1][2], xv[1][3])};
                    u32x4 o1 = {pk2(xv[2][0], xv[2][1]), pk2(xv[2][2], xv[2][3]), pk2(xv[3][0], xv[3][1]), pk2(xv[3][2], xv[3][3])};
                    *(u32x4*)(XB + (size_t)row * DM + k) = o0; *(u32x4*)(XB + (size_t)row * DM + k + 8) = o1;
                    if (G1F8 && MODE == 2) { u32x4 o8 = {pk4f8(F8_SX * xv[0][0], F8_SX * xv[0][1], F8_SX * xv[0][2], F8_SX * xv[0][3]), pk4f8(F8_SX * xv[1][0], F8_SX * xv[1][1], F8_SX * xv[1][2], F8_SX * xv[1][3]),
                                                         pk4f8(F8_SX * xv[2][0], F8_SX * xv[2][1], F8_SX * xv[2][2], F8_SX * xv[2][3]), pk4f8(F8_SX * xv[3][0], F8_SX * xv[3][1], F8_SX * xv[3][2], F8_SX * xv[3][3])};
                        *(u32x4*)(F.ws + WS_X8 + (size_t)row * DM + k) = o8; }
                }
#pragma unroll
                for (int j = 0; j < 4; ++j)
#pragma unroll
                    for (int i = 0; i < 4; ++i) acc = __builtin_amdgcn_mfma_f32_16x16x4f32(xv[j][i], bv[j][i], acc, 0, 0, 0);
            }
        }
#undef N1_LOAD
        ss += __shfl_xor(ss, 16); ss += __shfl_xor(ss, 32);
        const float rs = __builtin_amdgcn_rsqf(ss * (1.0f / DM) + EPS);
        if (kq == 0) rstd[row] = rs;
        const int n = r, rq = kq;
#pragma unroll
        for (int i = 0; i < 4; ++i) {
            const float rsi = __shfl(rs, 4 * rq + i); const int rowi = row0 + 4 * rq + i; const float v = acc[i] * rsi;
            if (n < 4) bbuf[rowi * 4 + n] = sigmoidf_(v);
            else if (n < 8) { const float x = v + IN_(F, 5)[l * 4 + (n - 4)]; const float sp = x > 20.f ? x : log1pf(__expf(x)); gbuf[rowi * 4 + (n - 4)] = -__expf(IN_(F, 4)[l * 4 + (n - 4)]) * sp; }
        }
    }
}

DI void norm2_pass(Frame& F, int l) {
    const bf16_t* XB = (const bf16_t*)(F.ws + WS_XR); unsigned char* X8 = F.ws + WS_X8;
    const unsigned char* wb = F.ws + WS_WSM2 + (size_t)l * 48 * DM * 4;
    unsigned* tokep = (unsigned*)(F.ws + WS_TOKEP); unsigned* list = (unsigned*)(F.ws + WS_LIST);
    float* gatel = (float*)(F.ws + WS_GATEL); float* rstdl = (float*)(F.ws + WS_RSTDL);
    LAS int* lcnt = misc_i(F, MS_LCNT); LAS int* gbase = misc_i(F, MS_GBASE);
    LAS unsigned char* wl = F.lds;
    LAS float* lg = (LAS float*)(F.lds + 98304 + F.wave * 3072);
    const int r = F.lane & 15, kq = F.lane >> 4;
    for (int ub = F.bid * NWAVES; ub < T_TOK / 16; ub += F.G * NWAVES) {
        const int unit = ub + F.wave, row0 = unit * 16, row = row0 + r;
        if (F.tid < NEXP) lcnt[F.tid] = 0;
        f32x4 acc[3]; acc[0] = acc[1] = acc[2] = (f32x4){0.f, 0.f, 0.f, 0.f}; float ss = 0.f;
#pragma unroll 1
        for (int hf = 0; hf < 2; ++hf) {
            __syncthreads();
#pragma unroll
            for (int p = 0; p < 12; ++p) { const int piece = p * 8 + F.wave, g6 = piece >> 4, kk = piece & 15;
                *(LAS u32x4*)(wl + piece * 1024 + F.lane * 16) = *(const u32x4*)(wb + (size_t)((g6 * 16 + hf * 8) * 2 + kk) * 1024 + F.lane * 16); }
            __syncthreads();
#pragma unroll 2
            for (int kb8 = 0; kb8 < 8; ++kb8) {
                const int k = (hf * 8 + kb8) * 64 + kq * 16;
                const u32x4 x0 = *(const u32x4*)(XB + (size_t)row * DM + k), x1 = *(const u32x4*)(XB + (size_t)row * DM + k + 8);
#pragma unroll
                for (int j = 0; j < 4; ++j) { const float a = bflo(x0[j]), b = bfhi(x0[j]), c = bflo(x1[j]), d = bfhi(x1[j]); ss += (a * a + b * b) + (c * c + d * d); }
                {
                    u32x4 o8 = {pk4f8(F8_SX * bflo(x0[0]), F8_SX * bfhi(x0[0]), F8_SX * bflo(x0[1]), F8_SX * bfhi(x0[1])), pk4f8(F8_SX * bflo(x0[2]), F8_SX * bfhi(x0[2]), F8_SX * bflo(x0[3]), F8_SX * bfhi(x0[3])),
                                pk4f8(F8_SX * bflo(x1[0]), F8_SX * bfhi(x1[0]), F8_SX * bflo(x1[1]), F8_SX * bfhi(x1[1])), pk4f8(F8_SX * bflo(x1[2]), F8_SX * bfhi(x1[2]), F8_SX * bflo(x1[3]), F8_SX * bfhi(x1[3]))};
                    *(u32x4*)(X8 + (size_t)row * DM + k) = o8; }
                const bf16x8 a0 = __builtin_bit_cast(bf16x8, x0), a1 = __builtin_bit_cast(bf16x8, x1);
#pragma unroll
                for (int nt = 0; nt < 3; ++nt)
#pragma unroll
                    for (int hl = 0; hl < 2; ++hl) {
                        const LAS unsigned char* fp = wl + ((hl * 3 + nt) * 16 + kb8 * 2) * 1024 + F.lane * 16;
                        acc[nt] = MFMA16(a0, *(const LAS bf16x8*)fp, acc[nt]);
                        acc[nt] = MFMA16(a1, *(const LAS bf16x8*)(fp + 1024), acc[nt]);
                    }
            }
        }
        ss += __shfl_xor(ss, 16); ss += __shfl_xor(ss, 32);
        const float rs = __builtin_amdgcn_rsqf(ss * (1.0f / DM) + EPS);
        {
            const int n = r, rq = kq;
#pragma unroll
            for (int i = 0; i < 4; ++i) { const float rsi = __shfl(rs, 4 * rq + i);
#pragma unroll
                for (int nt = 0; nt < 3; ++nt) lg[(4 * rq + i) * 48 + nt * 16 + n] = acc[nt][i] * rsi; }
        }
        LDS_WAIT(); asm volatile("" ::: "memory");
        int e0 = 0, e1 = 0, lp0 = 0, lp1 = 0; float g0 = 0.f, g1 = 0.f;
        if (F.lane < 16) {
            const LAS float* L = lg + F.lane * 48;
            float gl[4]; float gm = -3.0e38f; int gs = 0;
#pragma unroll
            for (int j = 0; j < 4; ++j) { gl[j] = L[j] + IN_(F, 14)[l * 4 + j]; if (gl[j] > gm) { gm = gl[j]; gs = j; } }
            float gz = 0.f;
#pragma unroll
            for (int j = 0; j < 4; ++j) gz += __expf(gl[j] - gm);
            const float pg = 1.0f / gz;
            float el[8];
#pragma unroll
            for (int j = 0; j < 8; ++j) el[j] = L[4 + gs * 8 + j] + IN_(F, 16)[l * 32 + gs * 8 + j];
            float m0 = -3.0e38f; int i0 = 0;
#pragma unroll
            for (int j = 0; j < 8; ++j) if (el[j] > m0) { m0 = el[j]; i0 = j; }
            float m1 = -3.0e38f; int i1 = 0;
#pragma unroll
            for (int j = 0; j < 8; ++j) if (j != i0 && el[j] > m1) { m1 = el[j]; i1 = j; }
            const float p1 = __expf(m1 - m0), den = 1.0f / (1.0f + p1);
            g0 = pg * den; g1 = pg * p1 * den; e0 = gs * 8 + i0; e1 = gs * 8 + i1;
        }
        __syncthreads();
        if (F.lane < 16) { lp0 = atomicAdd((int*)&lcnt[e0], 1); lp1 = atomicAdd((int*)&lcnt[e1], 1); }
        __syncthreads();
        if (F.tid < NEXP) { const int c = lcnt[F.tid]; gbase[F.tid] = c ? (int)atomicAdd(ctl(F) + CW_CNT + (l * NEXP + F.tid) * 64, (unsigned)c) : 0; }
        __syncthreads();
        if (F.lane < 16) {
            const int rowl = row0 + F.lane; const float rsl = __shfl(rs, F.lane);
            const int p0 = gbase[e0] + lp0, p1 = gbase[e1] + lp1;
            list[(size_t)e0 * LCAP + p0] = rowl; gatel[(size_t)e0 * LCAP + p0] = g0; rstdl[(size_t)e0 * LCAP + p0] = rsl;
            list[(size_t)e1 * LCAP + p1] = rowl; gatel[(size_t)e1 * LCAP + p1] = g1; rstdl[(size_t)e1 * LCAP + p1] = rsl;
            tokep[rowl * 2] = ((unsigned)e0 << 16) | (unsigned)p0; tokep[rowl * 2 + 1] = ((unsigned)e1 << 16) | (unsigned)p1;
        }
        __syncthreads();
    }
}

DI void final_pass(Frame& F) {
    const unsigned char* yb = F.ws + WS_RB; const unsigned* tokep = (const unsigned*)(F.ws + WS_TOKEP);
    const bf16_t* xrb = (const bf16_t*)(F.ws + WS_XR);
    LAS const int* tst = misc_i(F, MS_TST); const float* nw = IN_(F, 20);
    f32x4 w[4];
#pragma unroll
    for (int j = 0; j < 4; ++j) w[j] = *(const f32x4*)(nw + 256 * j + 4 * F.lane);
    const int gw = F.bid * NWAVES + F.wave, per = T_TOK / (F.G * NWAVES);
    for (int rb = gw * per; rb < (gw + 1) * per; rb += 4) {
        u32x2 xr[4][4]; unsigned ya[4][4], yc[4][4];
#pragma unroll
        for (int q = 0; q < 4; ++q) {
            const int row = rb + q;
            const unsigned e0 = tokep[row * 2], e1 = tokep[row * 2 + 1];
            const size_t s0 = (size_t)tst[e0 >> 16] * 256 + (e0 & 0xffffu), s1 = (size_t)tst[e1 >> 16] * 256 + (e1 & 0xffffu);
#pragma unroll
            for (int j = 0; j < 4; ++j) { const int k = 256 * j + 4 * F.lane;
                xr[q][j] = *(const u32x2*)(xrb + (size_t)row * DM + k); ya[q][j] = *(const unsigned*)(yb + s0 * DM + k); yc[q][j] = *(const unsigned*)(yb + s1 * DM + k); }
        }
#pragma unroll
        for (int q = 0; q < 4; ++q) {
            f32x4 v[4]; float ss = 0.f;
#pragma unroll
            for (int j = 0; j < 4; ++j) {
                const f32x4 yv = (f8x4(ya[q][j]) + f8x4(yc[q][j])) * (1.0f / F8_SY);
                v[j][0] = bflo(xr[q][j][0]) + yv[0]; v[j][1] = bfhi(xr[q][j][0]) + yv[1]; v[j][2] = bflo(xr[q][j][1]) + yv[2]; v[j][3] = bfhi(xr[q][j][1]) + yv[3];
                ss += v[j][0] * v[j][0] + v[j][1] * v[j][1] + v[j][2] * v[j][2] + v[j][3] * v[j][3];
            }
            const float rs = __builtin_amdgcn_rsqf(wave_sum(ss) * (1.0f / DM) + EPS);
#pragma unroll
            for (int j = 0; j < 4; ++j) __builtin_nontemporal_store(v[j] * rs * w[j], (f32x4*)(F.out + (size_t)(rb + q) * DM + 256 * j + 4 * F.lane));
        }
    }
}

constexpr int RS = 272;
DI void stage_raw(rsrc_t urs, int colbase, int n, LAS unsigned char* raw, int lane) {
    u32x4 v[17];
    const int vo = (n * CHK - 3 + (lane >> 4)) * (UW * 2) + (colbase + 8 * (lane & 15)) * 2;
#pragma unroll
    for (int i = 0; i < 17; ++i) v[i] = __builtin_amdgcn_raw_buffer_load_b128(urs, vo + (4 * i) * (UW * 2), 0, 0);
#pragma unroll
    for (int i = 0; i < 17; ++i) { const int rr = 4 * i + (lane >> 4); if (rr < 67) *(LAS u32x4*)(raw + rr * RS + 16 * (lane & 15)) = v[i]; }
    LDS_WAIT(); asm volatile("" ::: "memory");
}
DI f32x4 conv4(const LAS unsigned char* rp, const LAS float* wp) {
    f32x4 a = {0.f, 0.f, 0.f, 0.f};
#pragma unroll
    for (int tap = 0; tap < 4; ++tap) {
        const f32x4 w = *(const LAS f32x4*)(wp + tap * 128);
        const u32x2 x = *(const LAS u32x2*)(rp + tap * RS);
        a[0] += w[0] * bflo(x[0]); a[1] += w[1] * bfhi(x[0]); a[2] += w[2] * bflo(x[1]); a[3] += w[3] * bfhi(x[1]);
    }
    return silu4(a);
}
template <bool NORM>
DI void conv_to_frags(const LAS unsigned char* rawl, const LAS float* cwl, float post, rsrc_t drs, int v16, int soff0) {
#pragma unroll 1
    for (int rt = 0; rt < 4; ++rt) {
        const LAS unsigned char* rp = rawl + rt * 16 * RS;
        f32x4 a[8]; float ss = 0.f;
#pragma unroll
        for (int g8 = 0; g8 < 8; ++g8) { a[g8] = conv4(rp + 32 * g8, cwl + 16 * g8); ss += (a[g8][0] * a[g8][0] + a[g8][1] * a[g8][1]) + (a[g8][2] * a[g8][2] + a[g8][3] * a[g8][3]); }
        float sc = post;
        if (NORM) { ss += __shfl_xor(ss, 16); ss += __shfl_xor(ss, 32); sc = __builtin_amdgcn_rsqf(ss + EPS) * post; }
#pragma unroll
        for (int kc = 0; kc < 4; ++kc) BST128(pack8(a[2 * kc] * sc, a[2 * kc + 1] * sc), drs, v16, soff0 + (rt * 4 + kc) * 1024);
    }
}
template <bool NORM>
DI void conv_tile(const LAS unsigned char* rp, const LAS float* cwl, float post, bf16x8 (&P)[4]) {
    f32x4 a[8]; float ss = 0.f;
#pragma unroll
    for (int g8 = 0; g8 < 8; ++g8) { a[g8] = conv4(rp + 32 * g8, cwl + 16 * g8); ss += (a[g8][0] * a[g8][0] + a[g8][1] * a[g8][1]) + (a[g8][2] * a[g8][2] + a[g8][3] * a[g8][3]); }
    float sc = post;
    if (NORM) { ss += __shfl_xor(ss, 16); ss += __shfl_xor(ss, 32); sc = __builtin_amdgcn_rsqf(ss + EPS) * post; }
#pragma unroll
    for (int kc = 0; kc < 4; ++kc) P[kc] = pack8(a[2 * kc] * sc, a[2 * kc + 1] * sc);
}
#define BLD128C(rs, voff, soff) __builtin_bit_cast(bf16x8, __builtin_amdgcn_raw_buffer_load_b128((rs), (voff), (soff), 16))
DI void dn_chunk_local(Frame& F, int l, int unit) {
    const int s = unit >> 7, n = unit & 127, b = s >> 2, h = s & 3, tok0 = b * SEQ + n * CHK;
    const int lane = F.lane, r = lane & 15, kq = lane >> 4;
    const bf16_t* U = (const bf16_t*)(F.ws + WS_RB);
    unsigned char* dn = F.ws + WS_RA + (size_t)unit * DN_BYTES;
    const rsrc_t drs = mk_rsrc(dn, DN_BYTES); const int v16 = lane * 16, v8 = lane * 8;
    LAS unsigned char* raw = F.lds + F.wave * C1_WAVE_BYTES;
    LAS float* AT = (LAS float*)raw;
    LAS float* GC = (LAS float*)(F.lds + C1_EXTRA + MS_WAVE + F.wave * 512);
    const LAS float* CW = (const LAS float*)(F.lds + C1_EXTRA + MS_CONVW);
    const LAS unsigned char* rawl = raw + r * RS + 8 * kq;
    {
        float gv = ((const float*)(F.ws + WS_G))[(size_t)(tok0 + lane) * 4 + h];
        const float bt = ((const float*)(F.ws + WS_BETA))[(size_t)(tok0 + lane) * 4 + h];
#pragma unroll
        for (int off = 1; off < 64; off <<= 1) { const float t = __shfl_up(gv, off); if (lane >= off) gv += t; }
        const float glast = __shfl(gv, 63);
        GC[lane] = gv; GC[64 + lane] = bt;
        float* gt = (float*)(dn + DN_G);
        gt[lane] = bt; gt[64 + lane] = __expf(gv); gt[128 + lane] = __expf(glast - gv); gt[192 + lane] = __expf(glast);
    }
    bf16x8 sel0, sel1;
    {
        unsigned w0[2] = {0u, 0u};
        if (kq == (r >> 2)) { const int j = r & 3; w0[j >> 1] = (j & 1) ? 0x3F800000u : 0x00003F80u; }
        sel0 = mk8(w0[0], w0[1], 0u, 0u); sel1 = mk8(0u, 0u, w0[0], w0[1]);
    }
    const f32x4 z4 = {0.f, 0.f, 0.f, 0.f};
    const rsrc_t urs = mk_rsrc_u(U + (size_t)(b * SEQ) * UW, SEQ * UW * 2);
    stage_raw(urs, 1024 + h * DH, n, raw, lane);
#pragma unroll 1
    for (int rt = 0; rt < 4; ++rt) {
        bf16x8 P[4]; conv_tile<false>(rawl + rt * 16 * RS, CW + 2 * 512 + 4 * kq, 1.0f, P);
        u32x2 vo[8];
#pragma unroll
        for (int et = 0; et < 8; ++et) { const f32x4 d = MFMA16(P[et >> 1], (et & 1) ? sel1 : sel0, z4); vo[et] = (u32x2){pk2(d[0], d[1]), pk2(d[2], d[3])}; }
#pragma unroll
        for (int et = 0; et < 8; ++et) BST64(vo[et], drs, v8, DN_V + (et * 4 + rt) * 512);
    }
    stage_raw(urs, 512 + h * DH, n, raw, lane);
    bf16x8 kf[4][4];
#pragma unroll
    for (int rt = 0; rt < 4; ++rt) {
        __builtin_amdgcn_sched_barrier(0);
        conv_tile<true>(rawl + rt * 16 * RS, CW + 512 + 4 * kq, 1.0f, kf[rt]);
#pragma unroll
        for (int kc = 0; kc < 4; ++kc) BST128(kf[rt][kc], drs, v16, DN_K + (rt * 4 + kc) * 1024);
        __builtin_amdgcn_sched_barrier(0);
    }
#pragma unroll
    for (int dt = 0; dt < 8; ++dt)
#pragma unroll
        for (int cc = 0; cc < 2; ++cc) {
            const f32x4 d0 = MFMA16(kf[2 * cc][dt >> 1], (dt & 1) ? sel1 : sel0, z4);
            const f32x4 d1 = MFMA16(kf[2 * cc + 1][dt >> 1], (dt & 1) ? sel1 : sel0, z4);
            BST128(pack8(d0, d1), drs, v16, DN_KT + (dt * 2 + cc) * 1024);
        }
    stage_raw(urs, h * DH, n, raw, lane);
#pragma unroll
    for (int ct = 0; ct < 4; ++ct) {
        __builtin_amdgcn_sched_barrier(0);
        bf16x8 qf[4]; conv_tile<true>(rawl + ct * 16 * RS, CW + 4 * kq, 0.08838834764831845f, qf);
#pragma unroll
        for (int kc = 0; kc < 4; ++kc) BST128(qf[kc], drs, v16, DN_Q + (ct * 4 + kc) * 1024);
        const float gcc = GC[16 * ct + r]; const int c = 16 * ct + r;
        f32x4 tl[4];
#pragma unroll
        for (int ctp = 0; ctp < 4; ++ctp) {
            if (ctp <= ct) {
                f32x4 p = z4;
#pragma unroll
                for (int kc = 0; kc < 4; ++kc) p = MFMA16(kf[ctp][kc], qf[kc], p);
                const f32x4 gp = *(const LAS f32x4*)(GC + 16 * ctp + 4 * kq);
#pragma unroll
                for (int i = 0; i < 4; ++i) { const int cp = 16 * ctp + 4 * kq + i; tl[ctp][i] = (c >= cp) ? p[i] * __expf(gcc - gp[i]) : 0.f; }
            } else tl[ctp] = z4;
        }
        BST128(pack8(tl[0], tl[1]), drs, v16, DN_QK + ct * 1024);
        if (ct >= 2) BST128(pack8(tl[2], tl[3]), drs, v16, DN_QK + (2 + ct) * 1024);
    }
#pragma unroll
    for (int jt = 0; jt < 4; ++jt) {
        const f32x4 gj = *(const LAS f32x4*)(GC + 16 * jt + 4 * kq), bj = *(const LAS f32x4*)(GC + 64 + 16 * jt + 4 * kq);
#pragma unroll
        for (int ctp = 0; ctp <= jt; ++ctp) {
            f32x4 g = z4;
#pragma unroll
            for (int kc = 0; kc < 4; ++kc) g = MFMA16(kf[jt][kc], kf[ctp][kc], g);
            const float gcp = GC[16 * ctp + r]; const int cp = 16 * ctp + r;
            f32x4 o;
#pragma unroll
            for (int i = 0; i < 4; ++i) { const int j = 16 * jt + 4 * kq + i; o[i] = (j > cp) ? bj[i] * g[i] * __expf(gj[i] - gcp) : 0.f; }
            *(LAS f32x4*)(AT + cp * 64 + 16 * jt + 4 * kq) = o;
        }
    }
    LDS_WAIT(); asm volatile("" ::: "memory");
    {
        const int blk = lane >> 4, cq = lane & 15;
        float t[16];
#pragma unroll
        for (int c = 0; c < 16; ++c) t[c] = (c == cq) ? 1.f : 0.f;
        const LAS float* ab = AT + (16 * blk) * 64 + 16 * blk;
#pragma unroll
        for (int j = 0; j < 15; ++j)
#pragma unroll
            for (int c4 = (j + 1) >> 2; c4 < 4; ++c4) { const f32x4 a = *(const LAS f32x4*)(ab + j * 64 + 4 * c4);
#pragma unroll
                for (int i = 0; i < 4; ++i) if (4 * c4 + i > j) t[4 * c4 + i] -= a[i] * t[j]; }
        LAS unsigned char* DL = raw + 16384;
        u32x4 d0 = {pk2(t[0], t[1]), pk2(t[2], t[3]), pk2(t[4], t[5]), pk2(t[6], t[7])}, d1 = {pk2(t[8], t[9]), pk2(t[10], t[11]), pk2(t[12], t[13]), pk2(t[14], t[15])};
        *(LAS u32x4*)(DL + lane * 32) = d0; *(LAS u32x4*)(DL + lane * 32 + 16) = d1;
        LDS_WAIT(); asm volatile("" ::: "memory");
        f32x4 Z[4][4];
        f32x4 eye;
#pragma unroll
        for (int i = 0; i < 4; ++i) eye[i] = (4 * kq + i == r) ? 1.f : 0.f;
#pragma unroll
        for (int cb = 3; cb >= 0; --cb) {
            const u32x2 dl = *(const LAS u32x2*)(DL + ((cb * 16 + r) * 16 + 4 * kq) * 2);
            const bf16x8 Df = mk8(dl[0], dl[1], 0u, 0u);
            f32x4 R[4];
#pragma unroll
            for (int nt = 0; nt < 4; ++nt) R[nt] = (nt == cb) ? eye : z4;
#pragma unroll
            for (int t0 = cb + 1; t0 <= 3; t0 += 2) {
                const int t1 = t0 + 1;
                const f32x4 a0 = *(const LAS f32x4*)(AT + (16 * cb + r) * 64 + 16 * t0 + 4 * kq);
                f32x4 a1 = z4; if (t1 <= 3) a1 = *(const LAS f32x4*)(AT + (16 * cb + r) * 64 + 16 * t1 + 4 * kq);
                const bf16x8 Af = pack8(-a0, -a1);
#pragma unroll
                for (int nt = t0; nt < 4; ++nt) R[nt] = MFMA16(Af, pack8(Z[t0][nt], (t1 <= nt) ? Z[t1 <= 3 ? t1 : 3][nt] : z4), R[nt]);
            }
#pragma unroll
            for (int nt = cb; nt < 4; ++nt) Z[cb][nt] = MFMA16(Df, pack8(R[nt], z4), z4);
        }
#pragma unroll
        for (int f = 0; f < 6; ++f) {
            const int rt = f < 4 ? f : f - 2, cc = f < 4 ? 0 : 1;
            const f32x4 lo = (rt >= 2 * cc) ? Z[2 * cc][rt] : z4, hi = (rt >= 2 * cc + 1) ? Z[2 * cc + 1][rt] : z4;
            BST128(pack8(lo, hi), drs, v16, DN_T + f * 1024);
        }
    }
    LDS_WAIT(); asm volatile("" ::: "memory");
}

DI void ring_dma(const unsigned char* blk, LAS unsigned char* buf, int wave, int lane, bool skip_q) {
#pragma unroll
    for (int i = 0; i < 10; ++i) {
        const int c = wave + 8 * i;
        if (c < 77 && !(skip_q && ((c >= 32 && c < 48) || (c >= 54 && c < 60))))
            __builtin_amdgcn_global_load_lds((const unsigned*)(blk + c * 1024 + lane * 16), (LAS unsigned*)(buf + c * 1024), 16, 0, 0);
    }
}
template <int NT, bool OUT>
DI void slice_step(const LAS unsigned char* img, int lane, int rq, int sl, f32x4 (&S)[NT][8], f32x4 (&O)[4]) {
    const f32x4 z4 = {0.f, 0.f, 0.f, 0.f};
    const LAS unsigned char* fl = img + lane * 16;
    const LAS float* gt = (const LAS float*)(img + DN_G);
#define GT_BT(ct) (*(const LAS f32x4*)(gt + 16 * (ct) + 4 * rq))
#define GT_EG(ct) (*(const LAS f32x4*)(gt + 64 + 16 * (ct) + 4 * rq))
#define GT_ED(ct) (*(const LAS f32x4*)(gt + 128 + 16 * (ct) + 4 * rq))
    const float gl = gt[192];
    bf16x8 Sb[NT][4];
#pragma unroll
    for (int t = 0; t < NT; ++t)
#pragma unroll
        for (int kc = 0; kc < 4; ++kc) Sb[t][kc] = pack8(S[t][2 * kc], S[t][2 * kc + 1]);
    f32x4 X[NT][4], O1[4];
#pragma unroll
    for (int ct = 0; ct < 4; ++ct) {
#pragma unroll
        for (int t = 0; t < NT; ++t) X[t][ct] = z4;
        O1[ct] = z4;
#pragma unroll
        for (int kc = 0; kc < 4; ++kc) {
            const bf16x8 a = *(const LAS bf16x8*)(fl + DN_K + (ct * 4 + kc) * 1024);
#pragma unroll
            for (int t = 0; t < NT; ++t) X[t][ct] = MFMA16(a, Sb[t][kc], X[t][ct]);
            if (OUT) O1[ct] = MFMA16(Sb[0][kc], *(const LAS bf16x8*)(fl + DN_Q + (ct * 4 + kc) * 1024), O1[ct]);
        }
    }
    bf16x8 Yb[NT][2];
#pragma unroll
    for (int t = 0; t < NT; ++t) {
        f32x4 Y[4];
#pragma unroll
        for (int ct = 0; ct < 4; ++ct) {
            const f32x4 btc = GT_BT(ct), egc = GT_EG(ct);
            if (t == 0) { const u32x2 vv = *(const LAS u32x2*)(img + DN_V + (sl * 4 + ct) * 512 + lane * 8);
                const f32x4 v = {bflo(vv[0]), bfhi(vv[0]), bflo(vv[1]), bfhi(vv[1])};
                Y[ct] = btc * (v - egc * X[t][ct]); }
            else Y[ct] = -(btc * egc) * X[t][ct];
        }
        Yb[t][0] = pack8(Y[0], Y[1]); Yb[t][1] = pack8(Y[2], Y[3]);
    }
    f32x4 Vn[NT][4];
#pragma unroll
    for (int ct = 0; ct < 4; ++ct) {
        const bf16x8 a0 = *(const LAS bf16x8*)(fl + DN_T + ct * 1024);
#pragma unroll
        for (int t = 0; t < NT; ++t) Vn[t][ct] = MFMA16(a0, Yb[t][0], z4);
        if (ct >= 2) { const bf16x8 a1 = *(const LAS bf16x8*)(fl + DN_T + (2 + ct) * 1024);
#pragma unroll
            for (int t = 0; t < NT; ++t) Vn[t][ct] = MFMA16(a1, Yb[t][1], Vn[t][ct]); }
    }
    if (OUT) {
        const bf16x8 Vnb0 = pack8(Vn[0][0], Vn[0][1]), Vnb1 = pack8(Vn[0][2], Vn[0][3]);
#pragma unroll
        for (int ct = 0; ct < 4; ++ct) { f32x4 o2 = MFMA16(Vnb0, *(const LAS bf16x8*)(fl + DN_QK + ct * 1024), z4);
            if (ct >= 2) o2 = MFMA16(Vnb1, *(const LAS bf16x8*)(fl + DN_QK + (2 + ct) * 1024), o2);
            O[ct] = gt[64 + 16 * ct + (lane & 15)] * O1[ct] + o2; }
    }
    bf16x8 Vsb[NT][2];
#pragma unroll
    for (int t = 0; t < NT; ++t) { Vsb[t][0] = pack8(GT_ED(0) * Vn[t][0], GT_ED(1) * Vn[t][1]); Vsb[t][1] = pack8(GT_ED(2) * Vn[t][2], GT_ED(3) * Vn[t][3]); }
#pragma unroll
    for (int dt = 0; dt < 8; ++dt) {
#pragma unroll
        for (int t = 0; t < NT; ++t) S[t][dt] = S[t][dt] * gl;
#pragma unroll
        for (int cc = 0; cc < 2; ++cc) { const bf16x8 a = *(const LAS bf16x8*)(fl + DN_KT + (dt * 2 + cc) * 1024);
#pragma unroll
            for (int t = 0; t < NT; ++t) S[t][dt] = MFMA16(a, Vsb[t][cc], S[t][dt]); }
    }
#undef GT_BT
#undef GT_EG
#undef GT_ED
}
DI void scan_s1(Frame& F, int u) {
    const int lane = F.lane, n16 = lane & 15, rq = lane >> 4, sl = F.wave;
    const f32x4 z4 = {0.f, 0.f, 0.f, 0.f};
    const unsigned char* blk0 = F.ws + WS_RA + (size_t)(u * 8) * DN_BYTES;
    f32x4 S[2][8], Odummy[4];
#pragma unroll
    for (int dt = 0; dt < 8; ++dt) { S[0][dt] = z4;
#pragma unroll
        for (int i = 0; i < 4; ++i) S[1][dt][i] = (16 * dt + 4 * rq + i == 16 * sl + n16) ? 1.f : 0.f; }
    ring_dma(blk0, F.lds, F.wave, lane, true);
    VM_WAIT(); __builtin_amdgcn_s_barrier();
#pragma unroll 1
    for (int n = 0; n < 8; ++n) {
        if (n + 1 < 8) ring_dma(blk0 + (size_t)(n + 1) * DN_BYTES, F.lds + ((n + 1) & 1) * RING_IMG, F.wave, lane, true);
        slice_step<2, false>(F.lds + (n & 1) * RING_IMG, lane, rq, sl, S, Odummy);
        VM_WAIT(); LDS_WAIT(); __builtin_amdgcn_s_barrier();
    }
    float* qg = (float*)(F.ws + WS_QG) + ((size_t)(u * 8 + sl) * 8) * 256;
#pragma unroll
    for (int dt = 0; dt < 8; ++dt) *(f32x4*)(qg + dt * 256 + lane * 4) = S[0][dt];
    LAS unsigned char* pt = F.lds + F.wave * 4096;
#pragma unroll
    for (int dt = 0; dt < 8; ++dt) { u32x2 o = {pk2(S[1][dt][0], S[1][dt][1]), pk2(S[1][dt][2], S[1][dt][3])}; *(LAS u32x2*)(pt + n16 * 256 + (16 * dt + 4 * rq) * 2) = o; }
    LDS_WAIT(); asm volatile("" ::: "memory");
    unsigned char* pg = F.ws + WS_PG + (size_t)u * 32768;
    const int r = lane & 15, kq = lane >> 4;
#pragma unroll
    for (int dt = 0; dt < 8; ++dt) {
        const LAS unsigned short* p = (const LAS unsigned short*)(pt + (4 * kq) * 256 + (16 * dt + r) * 2);
        u32x2 o = {(unsigned)p[0] | ((unsigned)p[128] << 16), (unsigned)p[256] | ((unsigned)p[384] << 16)};
        *(u32x2*)(pg + (dt * 4 + (sl >> 1)) * 1024 + lane * 16 + (sl & 1) * 8) = o;
    }
    LDS_WAIT(); asm volatile("" ::: "memory");
}
DI void scan_s2(Frame& F, int s) {
    const int lane = F.lane, sl = F.wave;
    const f32x4 z4 = {0.f, 0.f, 0.f, 0.f};
    f32x4 S[8], Q[2][8];
#pragma unroll
    for (int dt = 0; dt < 8; ++dt) S[dt] = z4;
    const unsigned char* pg0 = F.ws + WS_PG + (size_t)(s * 16) * 32768;
    float* qg0 = (float*)(F.ws + WS_QG) + ((size_t)((s * 16) * 8 + sl) * 8) * 256;
#define S2_DMA(g, bufi) do { _Pragma("unroll") for (int i = 0; i < 4; ++i) { const int c = F.wave + 8 * i; \
        __builtin_amdgcn_global_load_lds((const unsigned*)(pg0 + (size_t)(g) * 32768 + c * 1024 + lane * 16), (LAS unsigned*)(F.lds + (bufi) * 32768 + c * 1024), 16, 0, 0); } } while (0)
#define S2_LDQ(g, qi) do { _Pragma("unroll") for (int dt = 0; dt < 8; ++dt) Q[qi][dt] = *(const f32x4*)(qg0 + (size_t)(g) * 16384 + dt * 256 + lane * 4); } while (0)
    S2_LDQ(0, 0); S2_DMA(0, 0); S2_LDQ(1, 1); S2_DMA(1, 1);
    VM_WAIT(); __builtin_amdgcn_s_barrier();
#pragma unroll 1
    for (int g2 = 0; g2 < 16; g2 += 2)
#pragma unroll
    for (int qi = 0; qi < 2; ++qi) {
        const int g = g2 + qi;
        if (g > 0) {
#pragma unroll
            for (int dt = 0; dt < 8; ++dt) *(f32x4*)(qg0 + (size_t)(g - 1) * 16384 + dt * 256 + lane * 4) = S[dt];
        }
        const LAS unsigned char* fl = F.lds + (g & 3) * 32768 + lane * 16;
        bf16x8 Sb[4];
#pragma unroll
        for (int kc = 0; kc < 4; ++kc) Sb[kc] = pack8(S[2 * kc], S[2 * kc + 1]);
#pragma unroll
        for (int dt = 0; dt < 8; ++dt) { f32x4 a = Q[qi][dt];
#pragma unroll
            for (int kc = 0; kc < 4; ++kc) a = MFMA16(*(const LAS bf16x8*)(fl + (dt * 4 + kc) * 1024), Sb[kc], a);
            S[dt] = a; }
        __builtin_amdgcn_sched_barrier(0);
        if (g + 2 < 16) { S2_LDQ(g + 2, qi); S2_DMA(g + 2, (g + 2) & 3); }
        __builtin_amdgcn_sched_barrier(0);
        if (g + 2 < 16) { if (g == 0) asm volatile("s_waitcnt vmcnt(12)" ::: "memory"); else asm volatile("s_waitcnt vmcnt(20)" ::: "memory"); }
        else asm volatile("s_waitcnt vmcnt(8)" ::: "memory");
        __builtin_amdgcn_sched_barrier(0);
        LDS_WAIT(); __builtin_amdgcn_s_barrier();
    }
    VM_WAIT();
#undef S2_DMA
#undef S2_LDQ
}
constexpr int PSUM_OFF = 2 * RING_IMG;
static_assert(PSUM_OFF + 4096 <= MISC_OFF, "LDS map");
DI void scan_s3(Frame& F, int l, int u) {
    const int lane = F.lane, n16 = lane & 15, rq = lane >> 4, sl = F.wave, s = u >> 4, g = u & 15, b = s >> 2, h = s & 3;
    bf16_t* U = (bf16_t*)(F.ws + WS_RB);
    const unsigned char* blk0 = F.ws + WS_RA + (size_t)(u * 8) * DN_BYTES;
    LAS float* psum = (LAS float*)(F.lds + PSUM_OFF);
    const float onw = IN_(F, 6)[l * DH + sl * 16 + n16];
    f32x4 S[1][8], O[4], Op[4]; u32x2 zp[4], zn[4];
    const f32x4 onw4 = *(const f32x4*)(IN_(F, 6) + l * DH + sl * 16 + 4 * rq);
    const float* sst = (const float*)(F.ws + WS_QG) + ((size_t)((u - 1) * 8 + sl) * 8) * 256;
#pragma unroll
    for (int dt = 0; dt < 8; ++dt) S[0][dt] = g > 0 ? *(const f32x4*)(sst + dt * 256 + lane * 4) : (f32x4){0.f, 0.f, 0.f, 0.f};
    ring_dma(blk0, F.lds, F.wave, lane, false);
    VM_WAIT(); __builtin_amdgcn_s_barrier();
#pragma unroll 1
    for (int n = 0; n <= 8; ++n) {
        if (n + 1 < 8) ring_dma(blk0 + (size_t)(n + 1) * DN_BYTES, F.lds + ((n + 1) & 1) * RING_IMG, F.wave, lane, false);
        if (n < 8) {
            const bf16_t* zb = U + (size_t)(b * SEQ + (g * 8 + n) * CHK + n16) * UW + 1536 + h * DH + sl * 16 + 4 * rq;
#pragma unroll
            for (int ct = 0; ct < 4; ++ct) zn[ct] = *(const u32x2*)(zb + (size_t)(16 * ct) * UW);
        }
        __builtin_amdgcn_sched_barrier(0);
        if (n > 0) {
            bf16_t* yb = U + (size_t)(b * SEQ + (g * 8 + n - 1) * CHK + n16) * UW + 512 + h * DH + sl * 16 + 4 * rq;
            const LAS float* ps = psum + ((n - 1) & 1) * 512;
#pragma unroll
            for (int ct = 0; ct < 4; ++ct) {
                float q = ps[16 * ct + n16];
#pragma unroll
                for (int w = 1; w < 8; ++w) q += ps[w * 64 + 16 * ct + n16];
                const float rs = __builtin_amdgcn_rsqf(q * (1.0f / DH) + EPS);
                const f32x4 o = Op[ct] * rs * onw4;
                const f32x4 yy = o * silu4((f32x4){bflo(zp[ct][0]), bfhi(zp[ct][0]), bflo(zp[ct][1]), bfhi(zp[ct][1])}); const float y0 = yy[0], y1 = yy[1], y2 = yy[2], y3 = yy[3];
                if (l == G2F8_L) *(unsigned*)(F.ws + WS_A8 + (size_t)(b * SEQ + (g * 8 + n - 1) * CHK + n16 + 16 * ct) * DM + h * DH + sl * 16 + 4 * rq) = pk4f8(F8_SA * y0, F8_SA * y1, F8_SA * y2, F8_SA * y3);
                else { u32x2 yv = {pk2(y0, y1), pk2(y2, y3)}; *(u32x2*)(yb + (size_t)(16 * ct) * UW) = yv; }
            }
        }
        __builtin_amdgcn_sched_barrier(0);
        if (n < 8) {
            slice_step<1, true>(F.lds + (n & 1) * RING_IMG, lane, rq, sl, S, O);
            LAS float* pw = psum + (n & 1) * 512 + sl * 64;
#pragma unroll
            for (int ct = 0; ct < 4; ++ct) {
                float q = (O[ct][0] * O[ct][0] + O[ct][1] * O[ct][1]) + (O[ct][2] * O[ct][2] + O[ct][3] * O[ct][3]);
                q += __shfl_xor(q, 16); q += __shfl_xor(q, 32);
                if (rq == 0) pw[16 * ct + n16] = q;
                Op[ct] = O[ct]; zp[ct] = zn[ct];
            }
        }
        VM_WAIT(); LDS_WAIT(); __builtin_amdgcn_s_barrier();
    }
}

DI void conformer_unit(Frame& F, int l, int unit) {
    const int cp = F.tid & 255, fh = F.tid >> 8, tok0 = unit * 64 + fh * 32, tl0 = tok0 & (SEQ - 1), ch = 2 * cp;
    bf16_t* U = (bf16_t*)(F.ws + WS_RB);
    const rsrc_t urs = mk_rsrc(U + (size_t)((unit * 64) & ~(SEQ - 1)) * UW, SEQ * UW * 2);
    const float* wdw = IN_(F, 7) + (size_t)l * 31 * 512;
    LAS float* cb = (LAS float*)F.lds;
    f32x2 w[31];
#pragma unroll
    for (int i = 0; i < 31; ++i) w[i] = *(const f32x2*)(wdw + i * 512 + ch);
    const f32x2 bias = *(const f32x2*)(IN_(F, 8) + l * 512 + ch);
    __syncthreads();
#pragma unroll 1
    for (int p = 0; p < 2; ++p) {
        const int t0 = tok0 + 16 * p, tl = tl0 + 16 * p;
        unsigned xin[46];
#pragma unroll
        for (int i = 0; i < 46; ++i) xin[i] = __builtin_amdgcn_raw_buffer_load_b32(urs, (tl - 30 + i) * (UW * 2) + (2048 + ch) * 2, 0, 0);
#pragma unroll
        for (int j = 0; j < 16; ++j) {
            f32x2 a = bias;
#pragma unroll
            for (int tap = 0; tap < 31; ++tap) { const f32x2 x = {bflo(xin[j + tap]), bfhi(xin[j + tap])}; a += w[tap] * x; }
            *(LAS f32x2*)(cb + (fh * 32 + 16 * p + j) * 512 + ch) = a;
        }
    }
    __syncthreads();
    const float* lg = IN_(F, 9) + l * 512; const float* lb = IN_(F, 10) + l * 512;
    const f32x4 g0 = *(const f32x4*)(lg + 8 * F.lane), g1 = *(const f32x4*)(lg + 8 * F.lane + 4), b0 = *(const f32x4*)(lb + 8 * F.lane), b1 = *(const f32x4*)(lb + 8 * F.lane + 4);
#pragma unroll 2
    for (int jj = 0; jj < 8; ++jj) {
        const int j = F.wave * 8 + jj;
        const f32x4 a = *(const LAS f32x4*)(cb + j * 512 + 8 * F.lane), b = *(const LAS f32x4*)(cb + j * 512 + 8 * F.lane + 4);
        const float mu = wave_sum((a[0] + a[1]) + (a[2] + a[3]) + (b[0] + b[1]) + (b[2] + b[3])) * (1.0f / 512.0f);
        const f32x4 da = a - mu, db = b - mu;
        const float var = wave_sum((da[0] * da[0] + da[1] * da[1]) + (da[2] * da[2] + da[3] * da[3]) + (db[0] * db[0] + db[1] * db[1]) + (db[2] * db[2] + db[3] * db[3])) * (1.0f / 512.0f);
        const float rs = __builtin_amdgcn_rsqf(var + EPS);
        const f32x4 oa = silu4(da * (g0 * rs) + b0), ob = silu4(db * (g1 * rs) + b1);
        const float o[8] = {oa[0], oa[1], oa[2], oa[3], ob[0], ob[1], ob[2], ob[3]};
        if (l == G2F8_L) { u32x2 ov = {pk4f8(F8_SA * o[0], F8_SA * o[1], F8_SA * o[2], F8_SA * o[3]), pk4f8(F8_SA * o[4], F8_SA * o[5], F8_SA * o[6], F8_SA * o[7])};
            *(u32x2*)(F.ws + WS_A8 + (size_t)(unit * 64 + j) * DM + 512 + 8 * F.lane) = ov; }
        else { u32x4 ov = {pk2(o[0], o[1]), pk2(o[2], o[3]), pk2(o[4], o[5]), pk2(o[6], o[7])};
            *(u32x4*)(U + (size_t)(unit * 64 + j) * UW + 1024 + 8 * F.lane) = ov; }
    }
}
#define IN(k) (lo <= (k) && (k) < hi)
#define SEAM(k) do { if (IN(k) && IN((k) + 1)) xcd_barrier(bar); } while (0)
#define PHASE_FRAME() Frame P = F; { int z_ = 0; asm volatile("" : "+s"(z_), "+v"(P.tid), "+v"(P.lane)); P.ws = F.ws + z_; P.out = F.out + z_; }
template <int l> DI void layer_phases(Frame& F, const XcdBarrier& bar, const int lo, const int hi) {
        const int pb = 1 + 9 * l;
        if (IN(pb + 0)) {
            PHASE_FRAME();
            if (l == 0) { norm1_pass<0>(P, 0); __syncthreads(); convert_dense<true>(P); convert_dense<false>(P); }
            else { build_seg_tables(P, 0); norm1_pass<2>(P, 1); }
        }
        SEAM(pb + 0);
        if (IN(pb + 1)) {
            PHASE_FRAME();
            if (G1F8 && l == 1) {
                pg8::DenseSched S; S.init(P.ws + WS_X8, DM / 2, P.ws + WS_WIN + (size_t)l * 3072 * DM * 2, T_TOK, 3072, DM / 2, P.G, P.bid);
                pg8::EpiG1 E{(bf16_t*)(P.ws + WS_RB), (const float*)(P.ws + WS_RSTD), 1.0f / (F8_SX * F8_SWI)};
                pg8::gemm_phase<true>(P.lds, DM / 2, S, E);
            } else {
                pg8::DenseSched S; S.init(P.ws + WS_XR, DM, (const bf16_t*)(P.ws + WS_WIN) + (size_t)l * 3072 * DM, T_TOK, 3072, DM, P.G, P.bid);
                pg8::EpiG1 E{(bf16_t*)(P.ws + WS_RB), (const float*)(P.ws + WS_RSTD), 1.0f};
                pg8::gemm_phase<false>(P.lds, DM, S, E);
            }
        }
        SEAM(pb + 1);
        if (IN(pb + 2)) {
            PHASE_FRAME();
            const int ub = P.bid * NWAVES; if (ub < 16 * NCHUNK) {
                const int hh = (ub >> 7) & 3;
                __syncthreads();
                for (int i = P.tid; i < 3 * 4 * 128; i += NTHR) { const int tz = i >> 9, tap = (i >> 7) & 3, d = i & 127;
                    ((LAS float*)(P.lds + C1_EXTRA + MS_CONVW))[i] = IN_(P, 3)[(size_t)l * 4 * 1536 + tap * 1536 + tz * 512 + hh * DH + d]; }
                __syncthreads();
                dn_chunk_local(P, l, ub + P.wave);
                VM_WAIT(); __syncthreads();
                scan_s1(P, ub >> 3);
            }
        }
        SEAM(pb + 2);
        if (IN(pb + 3)) {
            PHASE_FRAME();
            if (P.bid < 16) { scan_s2(P, P.bid); __syncthreads(); }
            else if (l == 0) convert_experts(P, 0, (P.bid - 16) * NWAVES + P.wave, (P.G - 16) * NWAVES);
            else convert_queue(P, nullptr);
        }
        SEAM(pb + 3);
        if (IN(pb + 4)) {
            PHASE_FRAME();
            if (P.bid < 256) scan_s3(P, l, P.bid);
            for (int unit = P.bid; unit < T_TOK / 64; unit += P.G) conformer_unit(P, l, unit);
        }
        SEAM(pb + 4);
        if (IN(pb + 5)) {
            PHASE_FRAME();
            if (l == G2F8_L) {
                pg8::DenseSched S; S.init(P.ws + WS_A8, DM / 2, P.ws + WS_WOUT + (size_t)l * DM * DM * 2, T_TOK, DM, DM / 2, P.G, P.bid);
                pg8::EpiRes E{(bf16_t*)(P.ws + WS_XR), 1.0f / (F8_SA * F8_SWO)};
                pg8::gemm_phase<true>(P.lds, DM / 2, S, E);
            } else {
                pg8::DenseSched S; S.init(P.ws + WS_RB + 512 * 2, UW, (const bf16_t*)(P.ws + WS_WOUT) + (size_t)l * DM * DM, T_TOK, DM, DM, P.G, P.bid);
                pg8::EpiRes E{(bf16_t*)(P.ws + WS_XR), 1.0f};
                pg8::gemm_phase<false>(P.lds, DM, S, E);
            }
        }
        SEAM(pb + 5);
        if (IN(pb + 6)) { PHASE_FRAME(); norm2_pass(P, l); }
        SEAM(pb + 6);
        if (IN(pb + 7)) {
            PHASE_FRAME();
            build_seg_tables(P, l);
            pg8::GroupSched<true> S; S.A = (const char*)(P.ws + WS_X8); S.Bt = (const char*)wgu_ptr(P, l); S.list = (const unsigned*)(P.ws + WS_LIST);
            S.tst = misc_i(P, MS_TST); S.cnt = misc_i(P, MS_CNT); S.K = DM / 2; S.ntile = S.tst[NEXP]; S.G = P.G; S.c = P.bid;
            pg8::EpiSwiGLU E{P.ws + WS_HID, (const float*)(P.ws + WS_RSTDL), misc_i(P, MS_CNT)};
            pg8::gemm_phase<true>(P.lds, DM / 2, S, E);
            if (l == 0) { __syncthreads(); unsigned* dn_ = ctl(P) + CW_DONE; if (P.tid == 0) __hip_atomic_fetch_add(dn_, 1u, __ATOMIC_RELAXED, __HIP_MEMORY_SCOPE_AGENT); convert_queue(P, dn_); }
        }
        SEAM(pb + 7);
        if (IN(pb + 8)) {
            PHASE_FRAME();
            build_seg_tables(P, l);
            pg8::GroupSched<false> S; S.A = (const char*)(P.ws + WS_HID); S.Bt = (const char*)wdn_ptr(P, l); S.list = nullptr;
            S.tst = misc_i(P, MS_TST); S.cnt = misc_i(P, MS_CNT); S.K = DEXP / 2; S.ntile = S.tst[NEXP]; S.G = P.G; S.c = P.bid;
            pg8::EpiDown E{P.ws + WS_RB, (const float*)(P.ws + WS_GATEL), misc_i(P, MS_CNT)};
            pg8::gemm_phase<true>(P.lds, DEXP / 2, S, E);
            if (l == 0) { __syncthreads(); unsigned* dn_ = ctl(P) + CW_DONE + 64; if (P.tid == 0) __hip_atomic_fetch_add(dn_, 1u, __ATOMIC_RELAXED, __HIP_MEMORY_SCOPE_AGENT); convert_queue(P, dn_); }
        }
        SEAM(pb + 8);
}

constexpr int NPHASE = 20;

__global__ void __launch_bounds__(NTHR, 2) mk_fwd(const float* __restrict__ i0, const float* __restrict__ i1, const float* __restrict__ i2, const float* __restrict__ i3, const float* __restrict__ i4, const float* __restrict__ i5, const float* __restrict__ i6, const float* __restrict__ i7, const float* __restrict__ i8, const float* __restrict__ i9, const float* __restrict__ i10, const float* __restrict__ i11, const float* __restrict__ i12, const float* __restrict__ i13, const float* __restrict__ i14, const float* __restrict__ i15, const float* __restrict__ i16, const float* __restrict__ i17, const float* __restrict__ i18, const float* __restrict__ i19, const float* __restrict__ i20, float* out_, unsigned char* ws_, int ph_lo, int ph_hi) {
    extern __shared__ __attribute__((aligned(16))) unsigned char lds_raw[];
    Frame F;
    F.lds = (LAS unsigned char*)lds_raw;
    F.tid = threadIdx.x; F.lane = F.tid & 63; F.wave = __builtin_amdgcn_readfirstlane(F.tid >> 6);
    F.G = gridDim.x; F.bid = blockIdx.x;
    F.in[0] = i0; F.in[1] = i1; F.in[2] = i2; F.in[3] = i3; F.in[4] = i4; F.in[5] = i5; F.in[6] = i6; F.in[7] = i7; F.in[8] = i8; F.in[9] = i9; F.in[10] = i10; F.in[11] = i11; F.in[12] = i12; F.in[13] = i13; F.in[14] = i14; F.in[15] = i15; F.in[16] = i16; F.in[17] = i17; F.in[18] = i18; F.in[19] = i19; F.in[20] = i20;
    F.out = out_; F.ws = ws_;
    if (F.tid < 4) ((LAS unsigned*)(F.lds + MISC_OFF + MS_BAR))[F.tid] = 0u;
    __syncthreads();
    XcdBarrier bar; bar.bar = ctl(F) + CW_BAR; bar.x = 0; bar.st = nullptr;
    if (!MK_PER_PHASE) bar = xcd_barrier_post(ctl(F) + CW_BAR, (volatile LAS unsigned*)(F.lds + MISC_OFF + MS_BAR));
    const int lo = ph_lo, hi = ph_hi;
#define IN(k) (lo <= (k) && (k) < hi)
#define SEAM(k) do { if (IN(k) && IN((k) + 1)) xcd_barrier(bar); } while (0)
#define PHASE_FRAME() Frame P = F; { int z_ = 0; asm volatile("" : "+s"(z_), "+v"(P.tid), "+v"(P.lane)); P.ws = F.ws + z_; P.out = F.out + z_; }

    layer_phases<0>(F, bar, lo, hi);
    layer_phases<1>(F, bar, lo, hi);
    if (IN(19)) { PHASE_FRAME(); build_seg_tables(P, 1); final_pass(P); }
#undef IN
#undef SEAM
}

extern "C" void kernel_launch(void* const* d_in, const int* in_sizes, int n_in, void* d_out, int out_size, void* d_ws, size_t ws_size, hipStream_t stream) {
    static int grid = 0;
    if (grid == 0) {
        if (n_in != 21 || ws_size < WS_END) { fprintf(stderr, "kernel_launch: unexpected inputs (n_in %d, ws %zu < %zu)\n", n_in, ws_size, (size_t)WS_END); grid = -1; return; }
        int dev = 0, cus = 0, per_cu = 0;
        if (hipGetDevice(&dev) != hipSuccess || hipDeviceGetAttribute(&cus, hipDeviceAttributeMultiprocessorCount, dev) != hipSuccess) { grid = -1; return; }
        if (hipFuncSetAttribute((const void*)mk_fwd, hipFuncAttributeMaxDynamicSharedMemorySize, LDS_BYTES) != hipSuccess) { grid = -1; return; }
        (void)hipOccupancyMaxActiveBlocksPerMultiprocessor(&per_cu, (const void*)mk_fwd, NTHR, LDS_BYTES);
        (void)hipGetLastError();
        grid = cus;
        if (grid < 256) { fprintf(stderr, "kernel_launch: needs >= 256 CUs (one DeltaNet segment per workgroup)\n"); grid = -1; return; }
        if (grid > 256) grid = 256;
    }
    if (grid < 0) return;
    (void)hipMemsetAsync((char*)d_ws + WS_CTL, 0, CTL_BYTES, stream);
    float* o_ = (float*)d_out; unsigned char* w_ = (unsigned char*)d_ws;
#if MK_PER_PHASE
    for (int p = 0; p < NPHASE; ++p) hipLaunchKernelGGL(mk_fwd, dim3(grid), dim3(NTHR), LDS_BYTES, stream, (const float*)d_in[0], (const float*)d_in[1], (const float*)d_in[2], (const float*)d_in[3], (const float*)d_in[4], (const float*)d_in[5], (const float*)d_in[6], (const float*)d_in[7], (const float*)d_in[8], (const float*)d_in[9], (const float*)d_in[10], (const float*)d_in[11], (const float*)d_in[12], (const float*)d_in[13], (const float*)d_in[14], (const float*)d_in[15], (const float*)d_in[16], (const float*)d_in[17], (const float*)d_in[18], (const float*)d_in[19], (const float*)d_in[20], o_, w_, p, p + 1);
#else
    hipLaunchKernelGGL(mk_fwd, dim3(grid), dim3(NTHR), LDS_BYTES, stream, (const float*)d_in[0], (const float*)d_in[1], (const float*)d_in[2], (const float*)d_in[3], (const float*)d_in[4], (const float*)d_in[5], (const float*)d_in[6], (const float*)d_in[7], (const float*)d_in[8], (const float*)d_in[9], (const float*)d_in[10], (const float*)d_in[11], (const float*)d_in[12], (const float*)d_in[13], (const float*)d_in[14], (const float*)d_in[15], (const float*)d_in[16], (const float*)d_in[17], (const float*)d_in[18], (const float*)d_in[19], (const float*)d_in[20], o_, w_, 0, NPHASE);
#endif
}
```

```cpp
#include <hip/hip_runtime.h>
#include <cstdio>
#include <cstdint>

#ifndef MK_PER_PHASE
#define MK_PER_PHASE 0
#endif

#define LAS __attribute__((address_space(3)))
#define GAS __attribute__((address_space(1)))
typedef unsigned short bf16_t;
typedef short bf16x8 __attribute__((ext_vector_type(8)));
typedef float f32x4 __attribute__((ext_vector_type(4)));
typedef float f32x2 __attribute__((ext_vector_type(2)));
typedef unsigned u32x4 __attribute__((ext_vector_type(4)));
typedef unsigned u32x2 __attribute__((ext_vector_type(2)));
typedef int i32x4 __attribute__((ext_vector_type(4)));
typedef int i32x8 __attribute__((ext_vector_type(8)));
typedef __bf16 bf16x2_t __attribute__((ext_vector_type(2)));
#define DI __device__ __forceinline__

constexpr int T_TOK = 32768, DM = 1024, SEQ = 8192, NHEAD = 4, DH = 128, CHK = 64, NCHUNK = 128;
constexpr int CIN = 3080, UW = 2560;
constexpr int NEXP = 32, DEXP = 512, LCAP = 32768;
constexpr float EPS = 1e-6f;
constexpr int NWAVES = 8, NTHR = 512;

constexpr size_t MiB = 1u << 20;
constexpr size_t WS_CTL = 0, CTL_BYTES = 64 * 1024;
constexpr size_t WS_WSM1 = 1 * MiB;
constexpr size_t WS_WSM2 = 1 * MiB + 128 * 1024;
constexpr size_t WS_RSTD = 2 * MiB;
constexpr size_t WS_G = 2 * MiB + 256 * 1024;
constexpr size_t WS_BETA = 3 * MiB;
constexpr size_t WS_TOKEP = 3 * MiB + 512 * 1024;
constexpr size_t WS_PSQ = 4 * MiB;
constexpr size_t WS_LIST = 8 * MiB;
constexpr size_t WS_GATEL = 12 * MiB;
constexpr size_t WS_RSTDL = 16 * MiB;
constexpr size_t WS_WIN = 20 * MiB;
constexpr size_t WS_WOUT = 32 * MiB;
constexpr size_t WS_WGU = 36 * MiB;
constexpr size_t WS_WDN = 100 * MiB;
constexpr size_t WS_RA = 132 * MiB;
constexpr size_t WS_X8 = WS_RA;
constexpr size_t WS_A8 = 68 * MiB;
constexpr size_t WS_HID = WS_RA + 64 * MiB;
constexpr size_t WS_RB = 288 * MiB;
constexpr size_t WS_PG = 448 * MiB;
constexpr size_t WS_QG = 456 * MiB;
constexpr size_t WS_XR = 472 * MiB;
constexpr size_t WS_END = 536 * MiB;
constexpr int DN_K = 0, DN_KT = 16384, DN_Q = 32768, DN_T = 49152, DN_QK = 55296, DN_V = 61440, DN_G = 77824, DN_BYTES = 78848;
constexpr int CW_BAR = 0, CW_CNT = 4096;
constexpr int CW_QHEAD = 8192 + 64, CW_DONE = 8192 + 128;

constexpr int STAGE_BYTES = 131072;
constexpr int C1_WAVE_BYTES = 18432;
constexpr int C1_EXTRA = 8 * C1_WAVE_BYTES;
constexpr int LDS_BYTES = 163840;
constexpr int MISC_OFF = LDS_BYTES - 2048;
constexpr int MS_BAR = 0;
constexpr int MS_CNT = 64;
constexpr int MS_TST = 256;
constexpr int MS_LCNT = 512;
constexpr int MS_GBASE = 768;
constexpr int MS_WAVE = 0;
constexpr int MS_CONVW = 4096;
constexpr int RING_IMG = 78848;
static_assert(2 * RING_IMG <= MISC_OFF && C1_EXTRA + MS_CONVW + 6144 <= MISC_OFF, "LDS map");

DI unsigned pk2(float a, float b) { f32x2 v = {a, b}; bf16x2_t r = __builtin_convertvector(v, bf16x2_t); return __builtin_bit_cast(unsigned, r); }
DI unsigned pk4f8(float a, float b, float c, float d) {
    a = __builtin_amdgcn_fmed3f(a, -448.f, 448.f); b = __builtin_amdgcn_fmed3f(b, -448.f, 448.f); c = __builtin_amdgcn_fmed3f(c, -448.f, 448.f); d = __builtin_amdgcn_fmed3f(d, -448.f, 448.f);
    int r = __builtin_amdgcn_cvt_pk_fp8_f32(a, b, 0, false); r = __builtin_amdgcn_cvt_pk_fp8_f32(c, d, r, true); return (unsigned)r; }
constexpr float F8_SX = 4.f, F8_SW1 = 64.f, F8_SH = 8.f, F8_SW2 = 32.f, F8_SY = 64.f, F8_SA = 8.f, F8_SWO = 64.f;
constexpr float F8_SWI = 64.f;
constexpr bool G1F8 = true;
constexpr int G2F8_L = 1;
DI f32x4 f8x4(unsigned w) { const f32x2 lo = __builtin_amdgcn_cvt_pk_f32_fp8((int)w, false), hi = __builtin_amdgcn_cvt_pk_f32_fp8((int)w, true); return (f32x4){lo[0], lo[1], hi[0], hi[1]}; }
DI float bflo(unsigned u) { return __builtin_bit_cast(float, u << 16); }
DI float bfhi(unsigned u) { return __builtin_bit_cast(float, u & 0xffff0000u); }
DI float wave_sum(float v) {
#pragma unroll
    for (int o = 1; o < 64; o <<= 1) v += __shfl_xor(v, o);
    return v;
}
template <int N> DI float dpp_ror_(float v) { return __builtin_bit_cast(float, __builtin_amdgcn_update_dpp(0, __builtin_bit_cast(int, v), 0x120 + N, 0xf, 0xf, false)); }
DI float row_sum16(float v) { v += dpp_ror_<8>(v); v += dpp_ror_<4>(v); v += dpp_ror_<2>(v); v += dpp_ror_<1>(v); return v; }
DI float siluf(float x) { return x * __builtin_amdgcn_rcpf(1.0f + __expf(-x)); }
DI float sigmoidf_(float x) { return __builtin_amdgcn_rcpf(1.0f + __expf(-x)); }
DI f32x4 silu4(const f32x4 a) {
    const f32x4 t = a * -1.44269504f;
    f32x4 d = {__builtin_amdgcn_exp2f(t[0]), __builtin_amdgcn_exp2f(t[1]), __builtin_amdgcn_exp2f(t[2]), __builtin_amdgcn_exp2f(t[3])}; d = d + 1.0f;
    const f32x4 r = {__builtin_amdgcn_rcpf(d[0]), __builtin_amdgcn_rcpf(d[1]), __builtin_amdgcn_rcpf(d[2]), __builtin_amdgcn_rcpf(d[3])};
    return a * r; }
#define LDS_WAIT() asm volatile("s_waitcnt lgkmcnt(0)" ::: "memory")
#define VM_WAIT() asm volatile("s_waitcnt vmcnt(0)" ::: "memory")
DI bf16x8 mk8(unsigned a, unsigned b, unsigned c, unsigned d) { u32x4 v = {a, b, c, d}; return __builtin_bit_cast(bf16x8, v); }
DI bf16x8 pack8(const f32x4& lo, const f32x4& hi) { return mk8(pk2(lo[0], lo[1]), pk2(lo[2], lo[3]), pk2(hi[0], hi[1]), pk2(hi[2], hi[3])); }
#define MFMA16(a, b, c) __builtin_amdgcn_mfma_f32_16x16x32_bf16((a), (b), (c), 0, 0, 0)
typedef __amdgpu_buffer_rsrc_t rsrc_t;
DI rsrc_t mk_rsrc(const void* p, unsigned bytes) { return __builtin_amdgcn_make_buffer_rsrc((void*)p, (short)0, (int)bytes, 0x00020000); }
DI rsrc_t mk_rsrc_u(const void* p, unsigned bytes) {
    const uint64_t a = (uint64_t)p; const unsigned lo = __builtin_amdgcn_readfirstlane((unsigned)a), hi = __builtin_amdgcn_readfirstlane((unsigned)(a >> 32));
    return mk_rsrc((const void*)(((uint64_t)hi << 32) | lo), bytes); }
#define BST128(v, rs, voff, soff) __builtin_amdgcn_raw_buffer_store_b128(__builtin_bit_cast(u32x4, (v)), (rs), (voff) + (soff), 0, 0)
#define BST64(v, rs, voff, soff) __builtin_amdgcn_raw_buffer_store_b64(__builtin_bit_cast(u32x2, (v)), (rs), (voff) + (soff), 0, 0)
#define BLD128(rs, voff, soff) __builtin_bit_cast(bf16x8, __builtin_amdgcn_raw_buffer_load_b128((rs), (voff), (soff), 0))
#define BLD64(rs, voff, soff) __builtin_amdgcn_raw_buffer_load_b64((rs), (voff), (soff), 0)

#define XB_TMO      128
#define XB_XCNT(j)  (256  + 64 * (j))
#define XB_XSUB(j)  (1280 + 64 * (j))
#define XB_XGEN(j)  (2304 + 64 * (j))
#define XB_TOP      3328
#define XB_TOPGEN   3392
#define XCD_BAR_WORDS 3456
#define XB_SPIN_CAP (1u << 18)
DI unsigned xb_ld(unsigned* p)              { return __hip_atomic_load(p, __ATOMIC_RELAXED, __HIP_MEMORY_SCOPE_AGENT); }
DI unsigned xb_add(unsigned* p, unsigned v) { return __hip_atomic_fetch_add(p, v, __ATOMIC_RELAXED, __HIP_MEMORY_SCOPE_AGENT); }
DI unsigned xb_xcc_id() { return (unsigned)__builtin_amdgcn_s_getreg((3 << 11) | 20) & 0xFu; }
#define XB_SPIN(cond, bar) do { unsigned _sp = 0; while (cond) { __builtin_amdgcn_s_sleep(1); \
    if ((++_sp & 255u) == 0u) { if (xb_ld(&(bar)[XB_TMO])) break; if (_sp > XB_SPIN_CAP) { atomicAdd(&(bar)[XB_TMO], 1u); break; } } } } while (0)
struct XcdBarrier { unsigned* bar; unsigned x; volatile LAS unsigned* st; };
DI XcdBarrier xcd_barrier_post(unsigned* bar, volatile LAS unsigned* st) {
    XcdBarrier b; b.bar = bar; b.x = xb_xcc_id(); b.st = st;
    if (threadIdx.x == 0) (void)xb_add(&bar[XB_XCNT(b.x)], 1u);
    return b;
}
DI void xcd_barrier_complete(unsigned* bar, unsigned x, unsigned& nloc, unsigned& nx) {
    const unsigned G = gridDim.x * gridDim.y * gridDim.z;
    unsigned sum, cnt, mine, sp = 0u;
    for (;;) {
        sum = 0u; cnt = 0u; mine = 0u;
#pragma unroll
        for (unsigned j = 0; j < 16; ++j) { const unsigned c = xb_ld(&bar[XB_XCNT(j)]); sum += c; cnt += (c > 0u) ? 1u : 0u; mine = (j == x) ? c : mine; }
        if (sum == G) break;
        __builtin_amdgcn_s_sleep(1);
        if ((++sp & 255u) == 0u) { if (xb_ld(&bar[XB_TMO])) break; if (sp > XB_SPIN_CAP) { atomicAdd(&bar[XB_TMO], 1u); break; } }
    }
    nloc = mine > 0u ? mine : 1u; nx = cnt > 0u ? cnt : 1u;
}
DI void xcd_barrier(const XcdBarrier& b) {
    asm volatile("s_waitcnt vmcnt(0)" ::: "memory");
    __syncthreads();
    if (threadIdx.x == 0) {
        unsigned* bar = b.bar;
        __builtin_amdgcn_s_waitcnt(0);
        unsigned nloc = b.st[0], nx = b.st[1];
        if (nloc == 0u) { xcd_barrier_complete(bar, b.x, nloc, nx); b.st[0] = nloc; b.st[1] = nx; }
        const unsigned old = xb_add(&bar[XB_XSUB(b.x)], 1u);
        const unsigned gen = old / nloc;
        if (old + 1u == (gen + 1u) * nloc) {
            __builtin_amdgcn_fence(__ATOMIC_RELEASE, "agent");
            asm volatile("s_waitcnt vmcnt(0)" ::: "memory");
            const unsigned og = xb_add(&bar[XB_TOP], 1u);
            const unsigned tg = og / nx;
            if (og + 1u == (tg + 1u) * nx) xb_add(&bar[XB_TOPGEN], 1u);
            else XB_SPIN(xb_ld(&bar[XB_TOPGEN]) == tg, bar);
            __builtin_amdgcn_fence(__ATOMIC_ACQUIRE, "agent");
            xb_add(&bar[XB_XGEN(b.x)], 1u);
            asm volatile("s_waitcnt vmcnt(0)" ::: "memory");
        } else {
            XB_SPIN(xb_ld(&bar[XB_XGEN(b.x)]) == gen, bar);
            __builtin_amdgcn_fence(__ATOMIC_ACQUIRE, "agent");
            asm volatile("s_waitcnt vmcnt(0)" ::: "memory");
        }
    }
    __syncthreads();
}

struct Frame {
    LAS unsigned char* lds;
    const float* in[21];
    float* out;
    unsigned char* ws;
    int tid, lane, wave, G, bid;
};
#define IN_(FR, i) ((FR).in[i])
DI LAS int* misc_i(Frame& F, int off) { return (LAS int*)(F.lds + MISC_OFF + off); }
DI unsigned* ctl(Frame& F) { return (unsigned*)(F.ws + WS_CTL); }

namespace pg8 {
constexpr int BM = 256, BK = 64, HALF = 128, HTB = HALF * BK * 2;
DI int lds_byte(int r, int c) { const int st = (r >> 4) * 2 + (c >> 5), rr = r & 15, cc = c & 31, ob = rr * 64 + cc * 2; return st * 1024 + (ob ^ (((ob >> 9) & 1) << 5)); }
DI void stage_rc(int b, int& R, int& C) { const int st = b / 1024, sb = b % 1024, swz = sb ^ (((sb >> 9) & 1) << 5); R = (st >> 1) * 16 + swz / 64; C = (st & 1) * 32 + (swz % 64) / 2; }
DI int perm32(int rho) { const int n = rho >> 4, i = rho & 15; return 8 * (i >> 2) + 4 * n + (i & 3); }
struct Unit { int pm, pn, e, lt; };

struct DenseSched {
    static constexpr bool GATHER = false;
    const char* A; const char* Bt; int lda, K, nM, nN, nwg, G, c;
    DI void init(const void* A_, int lda_, const void* Bt_, int M, int N, int K_, int G_, int c_) { A = (const char*)A_; Bt = (const char*)Bt_; lda = lda_; K = K_; nM = M / BM; nN = N / BM; nwg = nM * nN; G = G_; c = c_; }
    DI bool next(int i, Unit& u) const {
        const long L = (long)i * G + c; if (L >= nwg) return false;
        int wgid = (int)L; { const int q = nwg / 8, r = nwg % 8, xcd = wgid % 8, off = wgid / 8; wgid = (xcd < r ? xcd * (q + 1) : r * (q + 1) + (xcd - r) * q) + off; }
        const int nig = 8 * nN, gid = wgid / nig, fm = gid * 8, gsz = (nM - fm) < 8 ? (nM - fm) : 8;
        u.pm = fm + ((wgid % nig) % gsz); u.pn = (wgid % nig) / gsz; u.e = 0; u.lt = 0; return true;
    }
    DI const char* a_ptr(const Unit& u) const { return A + (size_t)u.pm * BM * lda * 2; }
    DI const char* b_ptr(const Unit& u) const { return Bt + (size_t)u.pn * BM * K * 2; }
    DI void a_off(const Unit&, const int (&R)[2], const int (&C)[2], unsigned (&v)[2][2]) const {
#pragma unroll
        for (int h = 0; h < 2; ++h)
#pragma unroll
            for (int i = 0; i < 2; ++i) v[h][i] = (unsigned)((h * HALF + R[i]) * lda + C[i]) * 2u;
    }
};
template <bool GATHER_> struct GroupSched {
    static constexpr bool GATHER = GATHER_;
    const char* A; const char* Bt; const unsigned* list; LAS const int* tst; LAS const int* cnt; int K, ntile, G, c;
    DI bool next(int i, Unit& u) const {
        int L = i * G + c;
        if (G == 256 && (i + 1) * 256 <= ntile * 4) { const int x = c & 7, j = c >> 3; L = i * 256 + (((x * 8) + (j >> 2)) << 2) + (j & 3); }
        if (L >= ntile * 4) return false;
        const int rt = L >> 2; int e = 0;
#pragma unroll 1
        for (int j = 16; j >= 1; j >>= 1) if (e + j < NEXP && tst[e + j] <= rt) e += j;
        u.pm = rt; u.pn = L & 3; u.e = e; u.lt = rt - tst[e]; return true;
    }
    DI const char* a_ptr(const Unit& u) const { return GATHER ? A : A + (size_t)u.pm * BM * K * 2; }
    DI const char* b_ptr(const Unit& u) const { return Bt + ((size_t)u.e * 1024 + (size_t)u.pn * BM) * K * 2; }
    DI void a_off(const Unit& u, const int (&R)[2], const int (&C)[2], unsigned (&v)[2][2]) const {
        if (GATHER) {
            const int ce = cnt[u.e];
#pragma unroll
            for (int h = 0; h < 2; ++h)
#pragma unroll
                for (int i = 0; i < 2; ++i) { int rin = u.lt * BM + h * HALF + R[i]; rin = rin < ce ? rin : ce - 1; const unsigned tok = list[(size_t)u.e * LCAP + rin]; v[h][i] = (tok * (unsigned)K + (unsigned)C[i]) * 2u; }
        } else {
#pragma unroll
            for (int h = 0; h < 2; ++h)
#pragma unroll
                for (int i = 0; i < 2; ++i) v[h][i] = (unsigned)((h * HALF + R[i]) * K + C[i]) * 2u;
        }
    }
};

template <bool F8> DI void mma2(const bf16x8 b0, const bf16x8 b1, const bf16x8 a0, const bf16x8 a1, f32x4& c) {
    if (F8) { const i32x8 B = __builtin_shufflevector(__builtin_bit_cast(i32x4, b0), __builtin_bit_cast(i32x4, b1), 0, 1, 2, 3, 4, 5, 6, 7), A = __builtin_shufflevector(__builtin_bit_cast(i32x4, a0), __builtin_bit_cast(i32x4, a1), 0, 1, 2, 3, 4, 5, 6, 7);
        asm volatile("v_mfma_f32_16x16x128_f8f6f4 %0, %1, %2, %0" : "+v"(c) : "v"(B), "v"(A)); }
    else { c = __builtin_amdgcn_mfma_f32_16x16x32_bf16(b0, a0, c, 0, 0, 0); c = __builtin_amdgcn_mfma_f32_16x16x32_bf16(b1, a1, c, 0, 0, 0); }
}
template <bool F8, class Epi, class Sched>
DI void gemm_phase(LAS unsigned char* lds, const int K, const Sched& S, const Epi& E) {
    const int tid = threadIdx.x, wid = __builtin_amdgcn_readfirstlane(tid >> 6), lane = tid & 63, wr = wid >> 2, wc = wid & 3, fr = lane & 15, fq = lane >> 4;
    const int nt = K / BK;
    int R[2], C[2]; unsigned voffB[2];
#pragma unroll
    for (int i = 0; i < 2; ++i) { stage_rc(tid * 16 + i * 8192, R[i], C[i]); const int Rb = Epi::PERM ? ((R[i] & ~31) + perm32(R[i] & 31)) : R[i]; voffB[i] = (unsigned)(Rb * K + C[i]) * 2u; }
    const size_t kstep = (size_t)(BK * 2);
    const size_t hstepB = (size_t)HALF * K * 2;
    const unsigned ldsw = (unsigned)wid * 1024u;
    const int aoff = lds_byte(wr * 64 + fr, fq * 8), boff = lds_byte(wc * 32 + fr, fq * 8);
#define PG8_SA(b, h) (((b) * 2 + (h)) * HTB)
#define PG8_SB(b, h) ((4 + (b) * 2 + (h)) * HTB)
#define PG8_STAGEB(bufoff, gbase) do { _Pragma("unroll") for (int _i = 0; _i < 2; ++_i) \
        __builtin_amdgcn_global_load_lds((const unsigned*)((const char*)(gbase) + voffB[_i]), (LAS unsigned*)(lds + (bufoff) + ldsw + _i * 8192), 16, 0, 0); } while (0)
#define PG8_STAGEA(bufoff, gbase, vv, h) do { _Pragma("unroll") for (int _i = 0; _i < 2; ++_i) \
        __builtin_amdgcn_global_load_lds((const unsigned*)((const char*)(gbase) + (vv)[h][_i]), (LAS unsigned*)(lds + (bufoff) + ldsw + _i * 8192), 16, 0, 0); } while (0)
#define PG8_LDA(dst, b, h) do { _Pragma("unroll") for (int m = 0; m < 4; ++m) _Pragma("unroll") for (int k = 0; k < 2; ++k) dst[m][k] = *(const LAS bf16x8*)(lds + PG8_SA(b, h) + aoff + m * 2048 + k * 1024); } while (0)
#define PG8_LDB(dst, b, h) do { _Pragma("unroll") for (int n = 0; n < 2; ++n) _Pragma("unroll") for (int k = 0; k < 2; ++k) dst[n][k] = *(const LAS bf16x8*)(lds + PG8_SB(b, h) + boff + n * 2048 + k * 1024); } while (0)
#define PG8_MMA(ai, bj, At, Bt) do { __builtin_amdgcn_s_setprio(1); _Pragma("unroll") for (int m = 0; m < 4; ++m) _Pragma("unroll") for (int n = 0; n < 2; ++n) \
        mma2<F8>(Bt[n][0], Bt[n][1], At[m][0], At[m][1], acc[ai][bj][m][n]); __builtin_amdgcn_s_setprio(0); } while (0)
#define PG8_WAIT_V(n) asm volatile("s_waitcnt vmcnt(" #n ")" ::: "memory")
#define PG8_WAIT_L(n) asm volatile("s_waitcnt lgkmcnt(" #n ")" ::: "memory")
#define PG8_BAR __builtin_amdgcn_s_barrier()
#define PG8_SCHED __builtin_amdgcn_sched_barrier(0)
    Unit cur, nxt; int ui = 0;
    if (!S.next(0, cur)) return;
    f32x4 acc[2][2][4][2];
#pragma unroll
    for (int a = 0; a < 2; ++a)
#pragma unroll
        for (int b = 0; b < 2; ++b)
#pragma unroll
            for (int m = 0; m < 4; ++m)
#pragma unroll
                for (int n = 0; n < 2; ++n) acc[a][b][m][n] = (f32x4){0.f, 0.f, 0.f, 0.f};
    bf16x8 At[4][2], B0[2][2], B1[2][2];
    unsigned vc[2][2], vn[2][2];
    const char* cB = S.b_ptr(cur);
    PG8_STAGEB(PG8_SB(0, 0), cB); PG8_STAGEB(PG8_SB(0, 1), cB + hstepB);
    S.a_off(cur, R, C, vc);
    const char* cA = S.a_ptr(cur);
    float epre[8]; E.pre(cur, wr, fr, epre);
    PG8_STAGEA(PG8_SA(0, 0), cA, vc, 0); PG8_STAGEA(PG8_SA(0, 1), cA, vc, 1);
    if (wr == 1) PG8_BAR;
    PG8_WAIT_V(2); PG8_BAR;
    PG8_STAGEB(PG8_SB(1, 0), cB + kstep); PG8_STAGEA(PG8_SA(1, 0), cA + kstep, vc, 0); PG8_STAGEB(PG8_SB(1, 1), cB + hstepB + kstep);
    PG8_WAIT_V(6); PG8_BAR;
    for (;;) {
        const bool has_next = S.next(ui + 1, nxt);
        const char* nA = has_next ? S.a_ptr(nxt) : cA; const char* nB = has_next ? S.b_ptr(nxt) : cB;
        if (Sched::GATHER) { if (has_next) S.a_off(nxt, R, C, vn); else {
#pragma unroll
            for (int h = 0; h < 2; ++h)
#pragma unroll
                for (int i = 0; i < 2; ++i) vn[h][i] = vc[h][i]; } }
#pragma unroll 1
        for (int t = 0; t < nt; t += 2) {
            const bool last = (t == nt - 2);
            const char* a1 = cA + (size_t)(t + 1) * kstep;
            const char* a2 = last ? nA : cA + (size_t)(t + 2) * kstep; const char* b2 = last ? nB : cB + (size_t)(t + 2) * kstep;
            const char* a3 = a2 + kstep; const char* b3 = b2 + kstep;
            unsigned v2[2][2];
#pragma unroll
            for (int h = 0; h < 2; ++h)
#pragma unroll
                for (int i = 0; i < 2; ++i) v2[h][i] = (Sched::GATHER && last) ? vn[h][i] : vc[h][i];
            PG8_LDB(B0, 0, 0); PG8_LDB(B1, 0, 1); PG8_SCHED; PG8_LDA(At, 0, 0); PG8_STAGEA(PG8_SA(1, 1), a1, vc, 1);
            PG8_WAIT_V(8); PG8_WAIT_L(0); PG8_BAR; PG8_MMA(0, 0, At, B0); PG8_MMA(0, 1, At, B1); PG8_BAR; PG8_SCHED;
            PG8_LDA(At, 0, 1); PG8_STAGEB(PG8_SB(0, 0), b2); PG8_STAGEB(PG8_SB(0, 1), b2 + hstepB); PG8_STAGEA(PG8_SA(0, 0), a2, v2, 0);
            PG8_WAIT_V(8); PG8_WAIT_L(0); PG8_BAR; PG8_MMA(1, 0, At, B0); PG8_MMA(1, 1, At, B1); PG8_BAR; PG8_SCHED;
            PG8_LDB(B0, 1, 0); PG8_LDB(B1, 1, 1); PG8_SCHED; PG8_LDA(At, 1, 0); PG8_STAGEA(PG8_SA(0, 1), a2, v2, 1);
            PG8_WAIT_V(8); PG8_WAIT_L(0); PG8_BAR; PG8_MMA(0, 0, At, B0); PG8_MMA(0, 1, At, B1); PG8_BAR; PG8_SCHED;
            PG8_LDA(At, 1, 1); PG8_STAGEB(PG8_SB(1, 0), b3); PG8_STAGEB(PG8_SB(1, 1), b3 + hstepB); PG8_STAGEA(PG8_SA(1, 0), a3, v2, 0);
            PG8_WAIT_V(8); PG8_WAIT_L(0); PG8_BAR; PG8_MMA(1, 0, At, B0); PG8_MMA(1, 1, At, B1); PG8_BAR; PG8_SCHED;
        }
        if (wr == 0) PG8_BAR;
        if (F8) { asm volatile("s_nop 15\n\ts_nop 15" : "+v"(acc[0][0][0][0]), "+v"(acc[0][0][0][1]), "+v"(acc[0][0][1][0]), "+v"(acc[0][0][1][1]), "+v"(acc[0][0][2][0]), "+v"(acc[0][0][2][1]), "+v"(acc[0][0][3][0]), "+v"(acc[0][0][3][1]), "+v"(acc[0][1][0][0]), "+v"(acc[0][1][0][1]), "+v"(acc[0][1][1][0]), "+v"(acc[0][1][1][1]), "+v"(acc[0][1][2][0]), "+v"(acc[0][1][2][1]), "+v"(acc[0][1][3][0]), "+v"(acc[0][1][3][1]));
                  asm volatile("" : "+v"(acc[1][0][0][0]), "+v"(acc[1][0][0][1]), "+v"(acc[1][0][1][0]), "+v"(acc[1][0][1][1]), "+v"(acc[1][0][2][0]), "+v"(acc[1][0][2][1]), "+v"(acc[1][0][3][0]), "+v"(acc[1][0][3][1]), "+v"(acc[1][1][0][0]), "+v"(acc[1][1][0][1]), "+v"(acc[1][1][1][0]), "+v"(acc[1][1][1][1]), "+v"(acc[1][1][2][0]), "+v"(acc[1][1][2][1]), "+v"(acc[1][1][3][0]), "+v"(acc[1][1][3][1])); }
        E(acc, cur, wr, wc, fr, fq, epre);
        if (!has_next) break;
#pragma unroll
        for (int a = 0; a < 2; ++a)
#pragma unroll
            for (int b = 0; b < 2; ++b)
#pragma unroll
                for (int m = 0; m < 4; ++m)
#pragma unroll
                    for (int n = 0; n < 2; ++n) acc[a][b][m][n] = (f32x4){0.f, 0.f, 0.f, 0.f};
        cur = nxt; cA = nA; cB = nB; ++ui;
        E.pre(cur, wr, fr, epre);
        if (Sched::GATHER) {
#pragma unroll
            for (int h = 0; h < 2; ++h)
#pragma unroll
                for (int i = 0; i < 2; ++i) vc[h][i] = vn[h][i]; }
        if (wr == 1) PG8_BAR;
    }
    PG8_WAIT_V(0);
    PG8_BAR;
#undef PG8_SA
#undef PG8_SB
#undef PG8_STAGEA
#undef PG8_STAGEB
#undef PG8_LDA
#undef PG8_LDB
#undef PG8_MMA
#undef PG8_WAIT_V
#undef PG8_WAIT_L
#undef PG8_BAR
#undef PG8_SCHED
}

struct EpiG1 {
    static constexpr bool PERM = true;
    bf16_t* U; const float* rstd; float sc;
    DI void pre(const Unit& u, int wr, int fr, float (&p)[8]) const {
#pragma unroll
        for (int ai = 0; ai < 2; ++ai)
#pragma unroll
            for (int m = 0; m < 4; ++m) p[ai * 4 + m] = rstd[u.pm * BM + wr * 64 + fr + ai * HALF + m * 16];
    }
    DI void operator()(const f32x4 (&acc)[2][2][4][2], const Unit& u, int wr, int wc, int fr, int fq, const float (&p)[8]) const {
        const int row0 = u.pm * BM + wr * 64 + fr;
#pragma unroll
        for (int ai = 0; ai < 2; ++ai)
#pragma unroll
            for (int m = 0; m < 4; ++m) {
                const int row = row0 + ai * HALF + m * 16; const float rs = p[ai * 4 + m] * sc;
                if (u.pn < 8) {
                    bf16_t* rowp = U + (size_t)row * UW + u.pn * BM + wc * 32 + 8 * fq;
#pragma unroll
                    for (int bj = 0; bj < 2; ++bj) { const f32x4 v0 = acc[ai][bj][m][0] * rs, v1 = acc[ai][bj][m][1] * rs;
                        u32x4 w = {pk2(v0[0], v0[1]), pk2(v0[2], v0[3]), pk2(v1[0], v1[1]), pk2(v1[2], v1[3])};
                        *(u32x4*)(rowp + bj * HALF) = w; }
                } else {
                    bf16_t* rowp = U + (size_t)row * UW + 2048 + (u.pn - 8) * HALF + wc * 32 + 8 * fq;
                    const float c1 = -1.44269504f * rs;
                    f32x4 o[2];
#pragma unroll
                    for (int n = 0; n < 2; ++n) { const f32x4 A = acc[ai][0][m][n] * rs, t = acc[ai][1][m][n] * c1;
                        f32x4 d = {__builtin_amdgcn_exp2f(t[0]), __builtin_amdgcn_exp2f(t[1]), __builtin_amdgcn_exp2f(t[2]), __builtin_amdgcn_exp2f(t[3])}; d = d + 1.0f;
                        const f32x4 r = {__builtin_amdgcn_rcpf(d[0]), __builtin_amdgcn_rcpf(d[1]), __builtin_amdgcn_rcpf(d[2]), __builtin_amdgcn_rcpf(d[3])}; o[n] = A * r; }
                    u32x4 w = {pk2(o[0][0], o[0][1]), pk2(o[0][2], o[0][3]), pk2(o[1][0], o[1][1]), pk2(o[1][2], o[1][3])};
                    *(u32x4*)rowp = w;
                }
            }
    }
};
struct EpiRes {
    static constexpr bool PERM = true;
    bf16_t* xr; float sc;
    DI void pre(const Unit&, int, int, float (&)[8]) const {}
    DI void operator()(const f32x4 (&acc)[2][2][4][2], const Unit& u, int wr, int wc, int fr, int fq, const float (&)[8]) const {
        const int row0 = u.pm * BM + wr * 64 + fr, col0 = u.pn * BM + wc * 32 + 8 * fq;
        u32x4 rv[2][4][2];
#pragma unroll
        for (int ai = 0; ai < 2; ++ai)
#pragma unroll
            for (int m = 0; m < 4; ++m)
#pragma unroll
                for (int bj = 0; bj < 2; ++bj) rv[ai][m][bj] = *(const u32x4*)(xr + (size_t)(row0 + ai * HALF + m * 16) * DM + col0 + bj * HALF);
        __builtin_amdgcn_sched_barrier(0);
#pragma unroll
        for (int ai = 0; ai < 2; ++ai) {
#pragma unroll
            for (int m = 0; m < 4; ++m) { bf16_t* rowp = xr + (size_t)(row0 + ai * HALF + m * 16) * DM + col0;
#pragma unroll
                for (int bj = 0; bj < 2; ++bj) { const u32x4 r = rv[ai][m][bj]; const f32x4 a0 = acc[ai][bj][m][0] * sc, a1 = acc[ai][bj][m][1] * sc;
                    u32x4 w = {pk2(bflo(r[0]) + a0[0], bfhi(r[0]) + a0[1]), pk2(bflo(r[1]) + a0[2], bfhi(r[1]) + a0[3]), pk2(bflo(r[2]) + a1[0], bfhi(r[2]) + a1[1]), pk2(bflo(r[3]) + a1[2], bfhi(r[3]) + a1[3])};
                    *(u32x4*)(rowp + bj * HALF) = w; } }
        }
    }
};
struct EpiSwiGLU {
    static constexpr bool PERM = true;
    unsigned char* hid; const float* rstdl; LAS const int* cnt;
    DI void pre(const Unit& u, int wr, int fr, float (&p)[8]) const {
        const int ce = cnt[u.e];
#pragma unroll
        for (int ai = 0; ai < 2; ++ai)
#pragma unroll
            for (int m = 0; m < 4; ++m) { int rin = u.lt * BM + ai * HALF + wr * 64 + m * 16 + fr; rin = rin < ce ? rin : ce - 1; p[ai * 4 + m] = rstdl[(size_t)u.e * LCAP + rin]; }
    }
    DI void operator()(const f32x4 (&acc)[2][2][4][2], const Unit& u, int wr, int wc, int fr, int fq, const float (&p)[8]) const {
#pragma unroll
        for (int ai = 0; ai < 2; ++ai)
#pragma unroll
            for (int m = 0; m < 4; ++m) {
                const int rl = ai * HALF + wr * 64 + m * 16 + fr;
                const float rs = p[ai * 4 + m] * (1.0f / (F8_SX * F8_SW1));
                unsigned char* rowp = hid + (size_t)(u.pm * BM + rl) * DEXP + u.pn * HALF + wc * 32 + 8 * fq;
                const float c1 = -1.44269504f * rs, c2 = rs * rs * F8_SH;
                f32x4 o[2];
#pragma unroll
                for (int n = 0; n < 2; ++n) { const f32x4 G = acc[ai][0][m][n], U = acc[ai][1][m][n], t = G * c1, gu = (G * U) * c2;
                    f32x4 d = {__builtin_amdgcn_exp2f(t[0]), __builtin_amdgcn_exp2f(t[1]), __builtin_amdgcn_exp2f(t[2]), __builtin_amdgcn_exp2f(t[3])}; d = d + 1.0f;
                    const f32x4 r = {__builtin_amdgcn_rcpf(d[0]), __builtin_amdgcn_rcpf(d[1]), __builtin_amdgcn_rcpf(d[2]), __builtin_amdgcn_rcpf(d[3])}; o[n] = gu * r; }
                u32x2 w = {pk4f8(o[0][0], o[0][1], o[0][2], o[0][3]), pk4f8(o[1][0], o[1][1], o[1][2], o[1][3])};
                *(u32x2*)rowp = w;
            }
    }
};
struct EpiDown {
    static constexpr bool PERM = true;
    unsigned char* yb; const float* gatel; LAS const int* cnt;
    DI void pre(const Unit& u, int wr, int fr, float (&p)[8]) const {
        const int ce = cnt[u.e];
#pragma unroll
        for (int ai = 0; ai < 2; ++ai)
#pragma unroll
            for (int m = 0; m < 4; ++m) { int rin = u.lt * BM + ai * HALF + wr * 64 + m * 16 + fr; rin = rin < ce ? rin : ce - 1; p[ai * 4 + m] = gatel[(size_t)u.e * LCAP + rin]; }
    }
    DI void operator()(const f32x4 (&acc)[2][2][4][2], const Unit& u, int wr, int wc, int fr, int fq, const float (&p)[8]) const {
#pragma unroll
        for (int ai = 0; ai < 2; ++ai)
#pragma unroll
            for (int m = 0; m < 4; ++m) {
                const int rl = ai * HALF + wr * 64 + m * 16 + fr;
                const float gt = p[ai * 4 + m] * (F8_SY / (F8_SH * F8_SW2));
                unsigned char* rowp = yb + (size_t)(u.pm * BM + rl) * DM + u.pn * BM + wc * 32 + 8 * fq;
#pragma unroll
                for (int bj = 0; bj < 2; ++bj) { const f32x4 v0 = acc[ai][bj][m][0] * gt, v1 = acc[ai][bj][m][1] * gt;
                    u32x2 w = {pk4f8(v0[0], v0[1], v0[2], v0[3]), pk4f8(v1[0], v1[1], v1[2], v1[3])};
                    *(u32x2*)(rowp + bj * HALF) = w; }
            }
    }
};
}

DI void tr_item(const float* W, int ldw, int scol0, int k0, const float* scale, bf16_t* WT, int Kdst, int drow0, LAS float* scr, int lane) {
    f32x4 v[8]; float sc[8];
#pragma unroll
    for (int i = 0; i < 8; ++i) { const int k = k0 + 8 * i + (lane >> 3); v[i] = __builtin_nontemporal_load((const f32x4*)(W + (size_t)k * ldw + scol0 + 4 * (lane & 7))); sc[i] = scale ? scale[k] : 1.f; }
#pragma unroll
    for (int i = 0; i < 8; ++i) { LAS float* p = scr + (8 * i + (lane >> 3)) * 33 + 4 * (lane & 7);
        p[0] = v[i][0] * sc[i]; p[1] = v[i][1] * sc[i]; p[2] = v[i][2] * sc[i]; p[3] = v[i][3] * sc[i]; }
    LDS_WAIT(); asm volatile("" ::: "memory");
#pragma unroll
    for (int j = 0; j < 4; ++j) { const int p = j * 64 + lane, n = p >> 3, c = p & 7; const LAS float* s = scr + (8 * c) * 33 + n;
        u32x4 o = {pk2(s[0 * 33], s[1 * 33]), pk2(s[2 * 33], s[3 * 33]), pk2(s[4 * 33], s[5 * 33]), pk2(s[6 * 33], s[7 * 33])};
        *(u32x4*)(WT + (size_t)(drow0 + n) * Kdst + k0 + 8 * c) = o; }
    LDS_WAIT(); asm volatile("" ::: "memory");
}
DI void tr_item8(const float* W, int ldw, int scol0, int k0, const float* scale, float mul, unsigned char* WT, int Kdst, int drow0, LAS float* scr, int lane) {
    f32x4 v[8]; float sc[8];
#pragma unroll
    for (int i = 0; i < 8; ++i) { const int k = k0 + 8 * i + (lane >> 3); v[i] = __builtin_nontemporal_load((const f32x4*)(W + (size_t)k * ldw + scol0 + 4 * (lane & 7))); sc[i] = (scale ? scale[k] : 1.f) * mul; }
#pragma unroll
    for (int i = 0; i < 8; ++i) { LAS float* p = scr + (8 * i + (lane >> 3)) * 33 + 4 * (lane & 7);
        p[0] = v[i][0] * sc[i]; p[1] = v[i][1] * sc[i]; p[2] = v[i][2] * sc[i]; p[3] = v[i][3] * sc[i]; }
    LDS_WAIT(); asm volatile("" ::: "memory");
#pragma unroll
    for (int j = 0; j < 2; ++j) { const int p = j * 64 + lane, n = p >> 2, c = p & 3; const LAS float* s = scr + (16 * c) * 33 + n;
        u32x4 o = {pk4f8(s[0 * 33], s[1 * 33], s[2 * 33], s[3 * 33]), pk4f8(s[4 * 33], s[5 * 33], s[6 * 33], s[7 * 33]), pk4f8(s[8 * 33], s[9 * 33], s[10 * 33], s[11 * 33]), pk4f8(s[12 * 33], s[13 * 33], s[14 * 33], s[15 * 33])};
        *(u32x4*)(WT + (size_t)(drow0 + n) * Kdst + k0 + 16 * c) = o; }
    LDS_WAIT(); asm volatile("" ::: "memory");
}
DI int pair_row(int c0) { return 256 * (c0 >> 7) + (c0 & 127); }
DI void tr_load(f32x4 (&v)[8], float (&sc)[8], const float* W, int ldw, int scol0, int k0, const float* scale, float mul, int lane) {
#pragma unroll
    for (int i = 0; i < 8; ++i) { const int k = k0 + 8 * i + (lane >> 3); v[i] = __builtin_nontemporal_load((const f32x4*)(W + (size_t)k * ldw + scol0 + 4 * (lane & 7))); sc[i] = (scale ? scale[k] : 1.f) * mul; }
}
DI void tr_fin(const f32x4 (&v)[8], const float (&sc)[8], bool f8, void* WT, int Kdst, int drow0, int k0, LAS float* scr, int lane) {
#pragma unroll
    for (int i = 0; i < 8; ++i) { LAS float* p = scr + (8 * i + (lane >> 3)) * 33 + 4 * (lane & 7);
        p[0] = v[i][0] * sc[i]; p[1] = v[i][1] * sc[i]; p[2] = v[i][2] * sc[i]; p[3] = v[i][3] * sc[i]; }
    LDS_WAIT(); asm volatile("" ::: "memory");
    if (f8) {
#pragma unroll
        for (int j = 0; j < 2; ++j) { const int p = j * 64 + lane, n = p >> 2, c = p & 3; const LAS float* s = scr + (16 * c) * 33 + n;
            u32x4 o = {pk4f8(s[0 * 33], s[1 * 33], s[2 * 33], s[3 * 33]), pk4f8(s[4 * 33], s[5 * 33], s[6 * 33], s[7 * 33]), pk4f8(s[8 * 33], s[9 * 33], s[10 * 33], s[11 * 33]), pk4f8(s[12 * 33], s[13 * 33], s[14 * 33], s[15 * 33])};
            *(u32x4*)((unsigned char*)WT + (size_t)(drow0 + n) * Kdst + k0 + 16 * c) = o; }
    } else {
#pragma unroll
        for (int j = 0; j < 4; ++j) { const int p = j * 64 + lane, n = p >> 3, c = p & 7; const LAS float* s = scr + (8 * c) * 33 + n;
            u32x4 o = {pk2(s[0 * 33], s[1 * 33]), pk2(s[2 * 33], s[3 * 33]), pk2(s[4 * 33], s[5 * 33]), pk2(s[6 * 33], s[7 * 33])};
            *(u32x4*)((bf16_t*)WT + (size_t)(drow0 + n) * Kdst + k0 + 8 * c) = o; }
    }
    LDS_WAIT(); asm volatile("" ::: "memory");
}
DI void dense_item(Frame& F, int l, int it0, const float*& W, int& ldw, int& scol0, int& k0, const float*& scale, float& mul, bool& f8, void*& WT, int& drow0) {
    const float* Win = IN_(F, 2) + (size_t)l * DM * CIN; bf16_t* WinT = (bf16_t*)(F.ws + WS_WIN) + (size_t)l * 3072 * DM;
    if (it0 < 1536) { W = Win; ldw = CIN; scale = IN_(F, 1) + l * DM; mul = (G1F8 && l == 1) ? F8_SWI : 1.f; f8 = G1F8 && l == 1; WT = WinT;
        if (it0 < 1024) { const int kb = it0 >> 6, nb = it0 & 63; scol0 = 32 * nb; k0 = 64 * kb; drow0 = 32 * nb; }
        else { const int it = it0 - 1024, kb = it >> 5, nb = it & 31, ab = nb >> 4, c0 = 32 * (nb & 15); scol0 = 2056 + 512 * ab + c0; k0 = 64 * kb; drow0 = 2048 + pair_row(c0) + 128 * ab; } }
    else { const int it = it0 - 1536, kb = it >> 5, nb = it & 31; W = IN_(F, 11) + (size_t)l * DM * DM; ldw = DM; scale = nullptr; mul = (l == G2F8_L) ? F8_SWO : 1.f; f8 = l == G2F8_L;
        WT = (bf16_t*)(F.ws + WS_WOUT) + (size_t)l * DM * DM; scol0 = 32 * nb; k0 = 64 * kb; drow0 = 32 * nb; }
}

template <bool SMALL> DI void convert_dense(Frame& F) {
    LAS float* scr = (LAS float*)(F.lds + F.wave * 16384);
    const int gw = F.bid * NWAVES + F.wave, NGW = F.G * NWAVES;
    if (!SMALL) {
        for (int it0 = gw; it0 < 2048; it0 += NGW) {
            f32x4 va[8], vb[8]; float sa[8], sb[8];
            const float *W0, *W1, *sc0, *sc1; int ldw0, ldw1, c0_, c1_, k0_, k1_, d0_, d1_; float m0, m1; bool f0, f1; void *T0, *T1;
            dense_item(F, 0, it0, W0, ldw0, c0_, k0_, sc0, m0, f0, T0, d0_); dense_item(F, 1, it0, W1, ldw1, c1_, k1_, sc1, m1, f1, T1, d1_);
            tr_load(va, sa, W0, ldw0, c0_, k0_, sc0, m0, F.lane); tr_load(vb, sb, W1, ldw1, c1_, k1_, sc1, m1, F.lane);
            __builtin_amdgcn_sched_barrier(0);
            tr_fin(va, sa, f0, T0, DM, d0_, k0_, scr, F.lane); tr_fin(vb, sb, f1, T1, DM, d1_, k1_, scr, F.lane);
        }
        return;
    }
    for (int l = 0; l < 2; ++l) {
        const float* Win = IN_(F, 2) + (size_t)l * DM * CIN; const float* nm = IN_(F, 1) + l * DM;
        {
        float* w2 = (float*)(F.ws + WS_WSM2) + (size_t)l * 48 * DM;
        const float* nf = IN_(F, 12) + l * DM; const float* wrg = IN_(F, 13) + (size_t)l * DM * 4; const float* wre = IN_(F, 15) + (size_t)l * DM * 32;
        for (int i = F.bid * NTHR + F.tid; i < 3 * 16 * 2 * 64; i += F.G * NTHR) { const int ln = i & 63, half = (i >> 6) & 1, kb = (i >> 7) & 15, nt = i >> 11;
            const int n = nt * 16 + (ln & 15), k0 = 64 * kb + 16 * (ln >> 4) + 8 * half;
            float wv[8], wl[8];
#pragma unroll
            for (int j = 0; j < 8; ++j) { const int k = k0 + j; const float w = n < 4 ? wrg[k * 4 + n] * nf[k] : (n < 36 ? wre[k * 32 + (n - 4)] * nf[k] : 0.f);
                const float h = bflo(pk2(w, 0.f)); wv[j] = w; wl[j] = w - h; }
            u32x4 hi = {pk2(wv[0], wv[1]), pk2(wv[2], wv[3]), pk2(wv[4], wv[5]), pk2(wv[6], wv[7])}, lo = {pk2(wl[0], wl[1]), pk2(wl[2], wl[3]), pk2(wl[4], wl[5]), pk2(wl[6], wl[7])};
            unsigned char* wb = (unsigned char*)w2;
            *(u32x4*)(wb + (size_t)(((0 * 3 + nt) * 16 + kb) * 2 + half) * 1024 + ln * 16) = hi;
            *(u32x4*)(wb + (size_t)(((1 * 3 + nt) * 16 + kb) * 2 + half) * 1024 + ln * 16) = lo; }
        }
    }
}
DI unsigned char* wgu_ptr(Frame& F, int l) { return l == 0 ? F.ws + WS_WGU : (unsigned char*)F.out; }
DI unsigned char* wdn_ptr(Frame& F, int l) { return l == 0 ? F.ws + WS_WDN : (unsigned char*)F.out + (size_t)NEXP * 1024 * DM; }
constexpr int CONV_ITEMS = NEXP * 768;
DI void convert_item(Frame& F, int l, int it, LAS float* scr) {
    if (it < NEXP * 512) { const int e = it >> 9, r = it & 511, gu = r >> 8, kb = (r >> 4) & 15, nb = r & 15, c0 = 32 * nb;
        const float* W = (gu ? IN_(F, 18) : IN_(F, 17)) + ((size_t)l * NEXP + e) * DM * DEXP;
        tr_item8(W, DEXP, c0, 64 * kb, IN_(F, 12) + l * DM, F8_SW1, wgu_ptr(F, l) + (size_t)e * 1024 * DM, DM, pair_row(c0) + 128 * gu, scr, F.lane); }
    else { it -= NEXP * 512; const int e = it >> 8, r = it & 255, kb = r >> 5, nb = r & 31;
        const float* W = IN_(F, 19) + ((size_t)l * NEXP + e) * DEXP * DM;
        tr_item8(W, DM, 32 * nb, 64 * kb, nullptr, F8_SW2, wdn_ptr(F, l) + (size_t)e * DM * DEXP, DEXP, 32 * nb, scr, F.lane); }
}
DI void expert_item(Frame& F, int l, int it, const float*& W, int& ldw, int& scol0, int& k0, const float*& scale, float& mul, void*& WT, int& Kdst, int& drow0) {
    if (it < NEXP * 512) { const int e = it >> 9, r = it & 511, gu = r >> 8, kb = (r >> 4) & 15, nb = r & 15, c0 = 32 * nb;
        W = (gu ? IN_(F, 18) : IN_(F, 17)) + ((size_t)l * NEXP + e) * DM * DEXP; ldw = DEXP; scol0 = c0; k0 = 64 * kb; scale = IN_(F, 12) + l * DM; mul = F8_SW1;
        WT = wgu_ptr(F, l) + (size_t)e * 1024 * DM; Kdst = DM; drow0 = pair_row(c0) + 128 * gu; }
    else { it -= NEXP * 512; const int e = it >> 8, r = it & 255, kb = r >> 5, nb = r & 31;
        W = IN_(F, 19) + ((size_t)l * NEXP + e) * DEXP * DM; ldw = DM; scol0 = 32 * nb; k0 = 64 * kb; scale = nullptr; mul = F8_SW2;
        WT = wdn_ptr(F, l) + (size_t)e * DM * DEXP; Kdst = DEXP; drow0 = 32 * nb; }
}
DI void convert_experts(Frame& F, int l, int gw, int NGW) {
    LAS float* scr = (LAS float*)(F.lds + F.wave * 16384);
    f32x4 va[8], vb[8]; float sa[8], sb[8];
    const float *W, *sc; int ldw, c0, k0a = 0, k0b = 0, Kda = 0, Kdb = 0, dra = 0, drb = 0; float mul; void *Ta = nullptr, *Tb = nullptr;
    int it = gw;
    if (it < CONV_ITEMS) { expert_item(F, l, it, W, ldw, c0, k0a, sc, mul, Ta, Kda, dra); tr_load(va, sa, W, ldw, c0, k0a, sc, mul, F.lane); }
#pragma unroll 1
    while (it < CONV_ITEMS) {
        int nx = it + NGW;
        if (nx < CONV_ITEMS) { expert_item(F, l, nx, W, ldw, c0, k0b, sc, mul, Tb, Kdb, drb); tr_load(vb, sb, W, ldw, c0, k0b, sc, mul, F.lane); }
        __builtin_amdgcn_sched_barrier(0);
        tr_fin(va, sa, true, Ta, Kda, dra, k0a, scr, F.lane);
        it = nx; if (it >= CONV_ITEMS) break;
        nx = it + NGW;
        if (nx < CONV_ITEMS) { expert_item(F, l, nx, W, ldw, c0, k0a, sc, mul, Ta, Kda, dra); tr_load(va, sa, W, ldw, c0, k0a, sc, mul, F.lane); }
        __builtin_amdgcn_sched_barrier(0);
        tr_fin(vb, sb, true, Tb, Kdb, drb, k0b, scr, F.lane);
        it = nx;
    }
}
DI void convert_queue(Frame& F, unsigned* done) {
    LAS float* scr = (LAS float*)(F.lds + F.wave * 16384);
    LAS unsigned* box = (LAS unsigned*)(F.lds + MISC_OFF + MS_LCNT);
    unsigned* qh = ctl(F) + CW_QHEAD;
    for (;;) {
        __syncthreads();
        if (F.tid == 0) {
            unsigned b = 0xffffffffu;
            if (!(done && __hip_atomic_load(done, __ATOMIC_RELAXED, __HIP_MEMORY_SCOPE_AGENT) >= (unsigned)F.G)) {
                b = __hip_atomic_fetch_add(qh, 8u, __ATOMIC_RELAXED, __HIP_MEMORY_SCOPE_AGENT); if (b >= (unsigned)CONV_ITEMS) b = 0xffffffffu; }
            box[0] = b;
        }
        __syncthreads();
        const unsigned b = box[0];
        if (b == 0xffffffffu) break;
        convert_item(F, 1, (int)b + F.wave, scr);
    }
    __syncthreads();
}

DI void build_seg_tables(Frame& F, int l) {
    LAS int* cnt = misc_i(F, MS_CNT); LAS int* tst = misc_i(F, MS_TST);
    __syncthreads();
    if (F.tid < 64) {
        int c = 0; if (F.lane < NEXP) c = (int)__hip_atomic_load(ctl(F) + CW_CNT + (l * NEXP + F.lane) * 64, __ATOMIC_RELAXED, __HIP_MEMORY_SCOPE_AGENT);
        const int t = (c + 255) >> 8; int incl = t;
#pragma unroll
        for (int o = 1; o < 32; o <<= 1) { const int v = __shfl_up(incl, o); if (F.lane >= o) incl += v; }
        if (F.lane < NEXP) { cnt[F.lane] = c; tst[F.lane] = incl - t; }
        if (F.lane == NEXP - 1) tst[NEXP] = incl;
    }
    __syncthreads();
}

template <int MODE>
DI void norm1_pass(Frame& F, int l) {
    const float* src = IN_(F, 0);
    bf16_t* XB = (bf16_t*)(F.ws + WS_XR); float* rstd = (float*)(F.ws + WS_RSTD);
    float* gbuf = (float*)(F.ws + WS_G); float* bbuf = (float*)(F.ws + WS_BETA);
    const unsigned char* yb = F.ws + WS_RB; const unsigned* tokep = (const unsigned*)(F.ws + WS_TOKEP);
    LAS const int* tst = misc_i(F, MS_TST);
    const int r = F.lane & 15, kq = F.lane >> 4;
    int unit = F.bid * NWAVES + F.wave, row0 = unit * 16, row = row0 + r;
    size_t s0 = 0, s1 = 0;
    if (MODE == 2) { const unsigned e0 = tokep[row * 2], e1 = tokep[row * 2 + 1]; s0 = (size_t)tst[e0 >> 16] * 256 + (e0 & 0xffffu); s1 = (size_t)tst[e1 >> 16] * 256 + (e1 & 0xffffu); }
    constexpr int CK = MODE == 0 ? 4 : 2, NCH = 16 / CK;
    f32x4 xf[2][CK][4]; u32x4 xu[2][CK][2], ya[2][CK], yc[2][CK];
#define N1_LOAD(buf, c) do { _Pragma("unroll") for (int q = 0; q < CK; ++q) { const int kb = CK * (c) + q, k = kb * 64 + kq * 16; \
            if (MODE == 0) { _Pragma("unroll") for (int j = 0; j < 4; ++j) xf[buf][q][j] = __builtin_nontemporal_load((const f32x4*)(src + (size_t)row * DM + kb * 64 + 4 * kq + 16 * j)); } \
            else { xu[buf][q][0] = *(const u32x4*)(XB + (size_t)row * DM + k); xu[buf][q][1] = *(const u32x4*)(XB + (size_t)row * DM + k + 8); } \
            if (MODE == 2) { ya[buf][q] = *(const u32x4*)(yb + s0 * DM + k); yc[buf][q] = *(const u32x4*)(yb + s1 * DM + k); } } } while (0)
    if (unit < T_TOK / 16) N1_LOAD(0, 0);
    __builtin_amdgcn_sched_barrier(0);
    LAS float* wl = (LAS float*)F.lds;
    {
        const float* Win = IN_(F, 2) + (size_t)l * DM * CIN + 2048; const float* nm = IN_(F, 1) + l * DM;
        for (int i = F.tid; i < 8 * DM; i += NTHR) { const int k = i >> 3, n = i & 7; wl[n * 1028 + k] = Win[(size_t)k * CIN + n] * nm[k]; }
        for (int i = F.tid; i < 8 * 1028; i += NTHR) wl[8 * 1028 + i] = 0.f;
        __syncthreads();
    }
    const LAS float* wsm = wl;
    while (unit < T_TOK / 16) {
        f32x4 acc = {0.f, 0.f, 0.f, 0.f}; float ss = 0.f;
#pragma unroll 1
        for (int c2 = 0; c2 < NCH; c2 += 2)
#pragma unroll
        for (int cb = 0; cb < 2; ++cb) {
            const int c = c2 + cb;
            if (cb == 0) N1_LOAD(1, c + 1); else if (c + 1 < NCH) N1_LOAD(0, c + 1);
            __builtin_amdgcn_sched_barrier(0);
#pragma unroll
            for (int q = 0; q < CK; ++q) {
                const int kb = CK * c + q, k = kb * 64 + kq * 16;
                const int kj0 = MODE == 0 ? kb * 64 + 4 * kq : k, kjs = MODE == 0 ? 16 : 4;
                f32x4 xv[4], bv[4];
#pragma unroll
                for (int j = 0; j < 4; ++j) bv[j] = *(const LAS f32x4*)(wsm + r * 1028 + kj0 + kjs * j);
                if (MODE == 0) {
#pragma unroll
                    for (int j = 0; j < 4; ++j) xv[j] = xf[cb][q][j];
                } else {
                    const u32x4 x0 = xu[cb][q][0], x1 = xu[cb][q][1];
#pragma unroll
                    for (int j = 0; j < 2; ++j) {
                        xv[0][2 * j] = bflo(x0[j]); xv[0][2 * j + 1] = bfhi(x0[j]); xv[1][2 * j] = bflo(x0[2 + j]); xv[1][2 * j + 1] = bfhi(x0[2 + j]);
                        xv[2][2 * j] = bflo(x1[j]); xv[2][2 * j + 1] = bfhi(x1[j]); xv[3][2 * j] = bflo(x1[2 + j]); xv[3][2 * j + 1] = bfhi(x1[2 + j]); }
                }
                if (MODE == 2) {
                    const u32x4 a = ya[cb][q], b = yc[cb][q];
#pragma unroll
                    for (int j = 0; j < 4; ++j) xv[j] += (f8x4(a[j]) + f8x4(b[j])) * (1.0f / F8_SY);
                }
#pragma unroll
                for (int j = 0; j < 4; ++j) ss += xv[j][0] * xv[j][0] + xv[j][1] * xv[j][1] + xv[j][2] * xv[j][2] + xv[j][3] * xv[j][3];
                if (MODE == 0) {
#pragma unroll
                    for (int j = 0; j < 4; ++j) { u32x2 o = {pk2(xv[j][0], xv[j][1]), pk2(xv[j][2], xv[j][3])}; *(u32x2*)(XB + (size_t)row * DM + kj0 + kjs * j) = o; }
                } else {
                    u32x4 o0 = {pk2(xv[0][0], xv[0][1]), pk2(xv[0][2], xv[0][3]), pk2(xv[1][0], xv[1][1]), pk2(xv[1][2], xv[1][3])};
                    u32x4 o1 = {pk2(xv[2][0], xv[2][1]), pk2(xv[2][2], xv[2][3]), pk2(xv[3][0], xv[3][1]), pk2(xv[3][2], xv[3][3])};
                    *(u32x4*)(XB + (size_t)row * DM + k) = o0; *(u32x4*)(XB + (size_t)row * DM + k + 8) = o1;
                    if (G1F8 && MODE == 2) { u32x4 o8 = {pk4f8(F8_SX * xv[0][0], F8_SX * xv[0][1], F8_SX * xv[0][2], F8_SX * xv[0][3]), pk4f8(F8_SX * xv[1][0], F8_SX * xv[1][1], F8_SX * xv[1][2], F8_SX * xv[1][3]),
                                                         pk4f8(F8_SX * xv[2][0], F8_SX * xv[2][1], F8_SX * xv[2][2], F8_SX * xv[2][3]), pk4f8(F8_SX * xv[3][0], F8_SX * xv[3][1], F8_SX * xv[3][2], F8_SX * xv[3][3])};
                        *(u32x4*)(F.ws + WS_X8 + (size_t)row * DM + k) = o8; }
                }
#pragma unroll
                for (int j = 0; j < 4; ++j)
#pragma unroll
                    for (int i = 0; i < 4; ++i) acc = __builtin_amdgcn_mfma_f32_16x16x4f32(xv[j][i], bv[j][i], acc, 0, 0, 0);
            }
        }
        ss += __shfl_xor(ss, 16); ss += __shfl_xor(ss, 32);
        const float rs = __builtin_amdgcn_rsqf(ss * (1.0f / DM) + EPS);
        if (kq == 0) rstd[row] = rs;
        const int n = r, rq = kq;
#pragma unroll
        for (int i = 0; i < 4; ++i) {
            const float rsi = __shfl(rs, 4 * rq + i); const int rowi = row0 + 4 * rq + i; const float v = acc[i] * rsi;
            if (n < 4) bbuf[rowi * 4 + n] = sigmoidf_(v);
            else if (n < 8) { const float x = v + IN_(F, 5)[l * 4 + (n - 4)]; const float sp = x > 20.f ? x : log1pf(__expf(x)); gbuf[rowi * 4 + (n - 4)] = -__expf(IN_(F, 4)[l * 4 + (n - 4)]) * sp; }
        }
        unit += F.G * NWAVES; if (unit >= T_TOK / 16) break;
        row0 = unit * 16; row = row0 + r;
        if (MODE == 2) { const unsigned e0 = tokep[row * 2], e1 = tokep[row * 2 + 1]; s0 = (size_t)tst[e0 >> 16] * 256 + (e0 & 0xffffu); s1 = (size_t)tst[e1 >> 16] * 256 + (e1 & 0xffffu); }
        N1_LOAD(0, 0);
    }
#undef N1_LOAD
}

DI void norm2_pass(Frame& F, int l) {
    const bf16_t* XB = (const bf16_t*)(F.ws + WS_XR); unsigned char* X8 = F.ws + WS_X8;
    const unsigned char* wb = F.ws + WS_WSM2 + (size_t)l * 48 * DM * 4;
    unsigned* tokep = (unsigned*)(F.ws + WS_TOKEP); unsigned* list = (unsigned*)(F.ws + WS_LIST);
    float* gatel = (float*)(F.ws + WS_GATEL); float* rstdl = (float*)(F.ws + WS_RSTDL);
    LAS int* lcnt = misc_i(F, MS_LCNT); LAS int* gbase = misc_i(F, MS_GBASE);
    LAS unsigned char* wl = F.lds;
    LAS float* lg = (LAS float*)(F.lds + 98304 + F.wave * 3072);
    const int r = F.lane & 15, kq = F.lane >> 4;
    for (int ub = F.bid * NWAVES; ub < T_TOK / 16; ub += F.G * NWAVES) {
        const int unit = ub + F.wave, row0 = unit * 16, row = row0 + r;
        if (F.tid < NEXP) lcnt[F.tid] = 0;
        f32x4 acc[3]; acc[0] = acc[1] = acc[2] = (f32x4){0.f, 0.f, 0.f, 0.f}; float ss = 0.f;
#pragma unroll 1
        for (int hf = 0; hf < 2; ++hf) {
            __syncthreads();
#pragma unroll
            for (int p = 0; p < 12; ++p) { const int piece = p * 8 + F.wave, g6 = piece >> 4, kk = piece & 15;
                *(LAS u32x4*)(wl + piece * 1024 + F.lane * 16) = *(const u32x4*)(wb + (size_t)((g6 * 16 + hf * 8) * 2 + kk) * 1024 + F.lane * 16); }
            __syncthreads();
#pragma unroll 2
            for (int kb8 = 0; kb8 < 8; ++kb8) {
                const int k = (hf * 8 + kb8) * 64 + kq * 16;
                const u32x4 x0 = *(const u32x4*)(XB + (size_t)row * DM + k), x1 = *(const u32x4*)(XB + (size_t)row * DM + k + 8);
#pragma unroll
                for (int j = 0; j < 4; ++j) { const float a = bflo(x0[j]), b = bfhi(x0[j]), c = bflo(x1[j]), d = bfhi(x1[j]); ss += (a * a + b * b) + (c * c + d * d); }
                {
                    u32x4 o8 = {pk4f8(F8_SX * bflo(x0[0]), F8_SX * bfhi(x0[0]), F8_SX * bflo(x0[1]), F8_SX * bfhi(x0[1])), pk4f8(F8_SX * bflo(x0[2]), F8_SX * bfhi(x0[2]), F8_SX * bflo(x0[3]), F8_SX * bfhi(x0[3])),
                                pk4f8(F8_SX * bflo(x1[0]), F8_SX * bfhi(x1[0]), F8_SX * bflo(x1[1]), F8_SX * bfhi(x1[1])), pk4f8(F8_SX * bflo(x1[2]), F8_SX * bfhi(x1[2]), F8_SX * bflo(x1[3]), F8_SX * bfhi(x1[3]))};
                    *(u32x4*)(X8 + (size_t)row * DM + k) = o8; }
                const bf16x8 a0 = __builtin_bit_cast(bf16x8, x0), a1 = __builtin_bit_cast(bf16x8, x1);
#pragma unroll
                for (int nt = 0; nt < 3; ++nt)
#pragma unroll
                    for (int hl = 0; hl < 2; ++hl) {
                        const LAS unsigned char* fp = wl + ((hl * 3 + nt) * 16 + kb8 * 2) * 1024 + F.lane * 16;
                        acc[nt] = MFMA16(a0, *(const LAS bf16x8*)fp, acc[nt]);
                        acc[nt] = MFMA16(a1, *(const LAS bf16x8*)(fp + 1024), acc[nt]);
                    }
            }
        }
        ss += __shfl_xor(ss, 16); ss += __shfl_xor(ss, 32);
        const float rs = __builtin_amdgcn_rsqf(ss * (1.0f / DM) + EPS);
        {
            const int n = r, rq = kq;
#pragma unroll
            for (int i = 0; i < 4; ++i) { const float rsi = __shfl(rs, 4 * rq + i);
#pragma unroll
                for (int nt = 0; nt < 3; ++nt) lg[(4 * rq + i) * 48 + nt * 16 + n] = acc[nt][i] * rsi; }
        }
        LDS_WAIT(); asm volatile("" ::: "memory");
        int e0 = 0, e1 = 0, lp0 = 0, lp1 = 0; float g0 = 0.f, g1 = 0.f;
        if (F.lane < 16) {
            const LAS float* L = lg + F.lane * 48;
            float gl[4]; float gm = -3.0e38f; int gs = 0;
#pragma unroll
            for (int j = 0; j < 4; ++j) { gl[j] = L[j] + IN_(F, 14)[l * 4 + j]; if (gl[j] > gm) { gm = gl[j]; gs = j; } }
            float gz = 0.f;
#pragma unroll
            for (int j = 0; j < 4; ++j) gz += __expf(gl[j] - gm);
            const float pg = 1.0f / gz;
            float el[8];
#pragma unroll
            for (int j = 0; j < 8; ++j) el[j] = L[4 + gs * 8 + j] + IN_(F, 16)[l * 32 + gs * 8 + j];
            float m0 = -3.0e38f; int i0 = 0;
#pragma unroll
            for (int j = 0; j < 8; ++j) if (el[j] > m0) { m0 = el[j]; i0 = j; }
            float m1 = -3.0e38f; int i1 = 0;
#pragma unroll
            for (int j = 0; j < 8; ++j) if (j != i0 && el[j] > m1) { m1 = el[j]; i1 = j; }
            const float p1 = __expf(m1 - m0), den = 1.0f / (1.0f + p1);
            g0 = pg * den; g1 = pg * p1 * den; e0 = gs * 8 + i0; e1 = gs * 8 + i1;
        }
        __syncthreads();
        if (F.lane < 16) { lp0 = atomicAdd((int*)&lcnt[e0], 1); lp1 = atomicAdd((int*)&lcnt[e1], 1); }
        __syncthreads();
        if (F.tid < NEXP) { const int c = lcnt[F.tid]; gbase[F.tid] = c ? (int)atomicAdd(ctl(F) + CW_CNT + (l * NEXP + F.tid) * 64, (unsigned)c) : 0; }
        __syncthreads();
        if (F.lane < 16) {
            const int rowl = row0 + F.lane; const float rsl = __shfl(rs, F.lane);
            const int p0 = gbase[e0] + lp0, p1 = gbase[e1] + lp1;
            list[(size_t)e0 * LCAP + p0] = rowl; gatel[(size_t)e0 * LCAP + p0] = g0; rstdl[(size_t)e0 * LCAP + p0] = rsl;
            list[(size_t)e1 * LCAP + p1] = rowl; gatel[(size_t)e1 * LCAP + p1] = g1; rstdl[(size_t)e1 * LCAP + p1] = rsl;
            tokep[rowl * 2] = ((unsigned)e0 << 16) | (unsigned)p0; tokep[rowl * 2 + 1] = ((unsigned)e1 << 16) | (unsigned)p1;
        }
        __syncthreads();
    }
}

DI void final_pass(Frame& F) {
    const unsigned char* yb = F.ws + WS_RB; const unsigned* tokep = (const unsigned*)(F.ws + WS_TOKEP);
    const bf16_t* xrb = (const bf16_t*)(F.ws + WS_XR);
    LAS const int* tst = misc_i(F, MS_TST); const float* nw = IN_(F, 20);
    f32x4 w[4];
#pragma unroll
    for (int j = 0; j < 4; ++j) w[j] = *(const f32x4*)(nw + 256 * j + 4 * F.lane);
    const int gw = F.bid * NWAVES + F.wave, per = T_TOK / (F.G * NWAVES);
    for (int rb = gw * per; rb < (gw + 1) * per; rb += 4) {
        u32x2 xr[4][4]; unsigned ya[4][4], yc[4][4];
#pragma unroll
        for (int q = 0; q < 4; ++q) {
            const int row = rb + q;
            const unsigned e0 = tokep[row * 2], e1 = tokep[row * 2 + 1];
            const size_t s0 = (size_t)tst[e0 >> 16] * 256 + (e0 & 0xffffu), s1 = (size_t)tst[e1 >> 16] * 256 + (e1 & 0xffffu);
#pragma unroll
            for (int j = 0; j < 4; ++j) { const int k = 256 * j + 4 * F.lane;
                xr[q][j] = *(const u32x2*)(xrb + (size_t)row * DM + k); ya[q][j] = *(const unsigned*)(yb + s0 * DM + k); yc[q][j] = *(const unsigned*)(yb + s1 * DM + k); }
        }
#pragma unroll
        for (int q = 0; q < 4; ++q) {
            f32x4 v[4]; float ss = 0.f;
#pragma unroll
            for (int j = 0; j < 4; ++j) {
                const f32x4 yv = (f8x4(ya[q][j]) + f8x4(yc[q][j])) * (1.0f / F8_SY);
                v[j][0] = bflo(xr[q][j][0]) + yv[0]; v[j][1] = bfhi(xr[q][j][0]) + yv[1]; v[j][2] = bflo(xr[q][j][1]) + yv[2]; v[j][3] = bfhi(xr[q][j][1]) + yv[3];
                ss += v[j][0] * v[j][0] + v[j][1] * v[j][1] + v[j][2] * v[j][2] + v[j][3] * v[j][3];
            }
            const float rs = __builtin_amdgcn_rsqf(wave_sum(ss) * (1.0f / DM) + EPS);
#pragma unroll
            for (int j = 0; j < 4; ++j) __builtin_nontemporal_store(v[j] * rs * w[j], (f32x4*)(F.out + (size_t)(rb + q) * DM + 256 * j + 4 * F.lane));
        }
    }
}

constexpr int RS = 272;
DI void stage_load(rsrc_t urs, int colbase, int n, int lane, u32x4 (&v)[17]) {
    const int vo = (n * CHK - 3 + (lane >> 4)) * (UW * 2) + (colbase + 8 * (lane & 15)) * 2;
#pragma unroll
    for (int i = 0; i < 17; ++i) v[i] = __builtin_amdgcn_raw_buffer_load_b128(urs, vo + (4 * i) * (UW * 2), 0, 0);
}
DI void stage_store(const u32x4 (&v)[17], LAS unsigned char* raw, int lane) {
#pragma unroll
    for (int i = 0; i < 17; ++i) { const int rr = 4 * i + (lane >> 4); if (rr < 67) *(LAS u32x4*)(raw + rr * RS + 16 * (lane & 15)) = v[i]; }
    LDS_WAIT(); asm volatile("" ::: "memory");
}
DI void stage_raw(rsrc_t urs, int colbase, int n, LAS unsigned char* raw, int lane) { u32x4 v[17]; stage_load(urs, colbase, n, lane, v); stage_store(v, raw, lane); }
DI f32x4 conv4(const LAS unsigned char* rp, const LAS float* wp) {
    f32x4 a = {0.f, 0.f, 0.f, 0.f};
#pragma unroll
    for (int tap = 0; tap < 4; ++tap) {
        const f32x4 w = *(const LAS f32x4*)(wp + tap * 128);
        const u32x2 x = *(const LAS u32x2*)(rp + tap * RS);
        a[0] += w[0] * bflo(x[0]); a[1] += w[1] * bfhi(x[0]); a[2] += w[2] * bflo(x[1]); a[3] += w[3] * bfhi(x[1]);
    }
    return silu4(a);
}
template <bool NORM>
DI void conv_to_frags(const LAS unsigned char* rawl, const LAS float* cwl, float post, rsrc_t drs, int v16, int soff0) {
#pragma unroll 1
    for (int rt = 0; rt < 4; ++rt) {
        const LAS unsigned char* rp = rawl + rt * 16 * RS;
        f32x4 a[8]; float ss = 0.f;
#pragma unroll
        for (int g8 = 0; g8 < 8; ++g8) { a[g8] = conv4(rp + 32 * g8, cwl + 16 * g8); ss += (a[g8][0] * a[g8][0] + a[g8][1] * a[g8][1]) + (a[g8][2] * a[g8][2] + a[g8][3] * a[g8][3]); }
        float sc = post;
        if (NORM) { ss += __shfl_xor(ss, 16); ss += __shfl_xor(ss, 32); sc = __builtin_amdgcn_rsqf(ss + EPS) * post; }
#pragma unroll
        for (int kc = 0; kc < 4; ++kc) BST128(pack8(a[2 * kc] * sc, a[2 * kc + 1] * sc), drs, v16, soff0 + (rt * 4 + kc) * 1024);
    }
}
template <bool NORM>
DI void conv_tile(const LAS unsigned char* rp, const LAS float* cwl, float post, bf16x8 (&P)[4]) {
    f32x4 a[8]; float ss = 0.f;
#pragma unroll
    for (int g8 = 0; g8 < 8; ++g8) { a[g8] = conv4(rp + 32 * g8, cwl + 16 * g8); ss += (a[g8][0] * a[g8][0] + a[g8][1] * a[g8][1]) + (a[g8][2] * a[g8][2] + a[g8][3] * a[g8][3]); }
    float sc = post;
    if (NORM) { ss += __shfl_xor(ss, 16); ss += __shfl_xor(ss, 32); sc = __builtin_amdgcn_rsqf(ss + EPS) * post; }
#pragma unroll
    for (int kc = 0; kc < 4; ++kc) P[kc] = pack8(a[2 * kc] * sc, a[2 * kc + 1] * sc);
}
#define BLD128C(rs, voff, soff) __builtin_bit_cast(bf16x8, __builtin_amdgcn_raw_buffer_load_b128((rs), (voff), (soff), 16))
DI void dn_chunk_local(Frame& F, int l, int unit, const u32x4 (&svv)[17]) {
    const int s = unit >> 7, n = unit & 127, b = s >> 2, h = s & 3, tok0 = b * SEQ + n * CHK;
    const int lane = F.lane, r = lane & 15, kq = lane >> 4;
    const bf16_t* U = (const bf16_t*)(F.ws + WS_RB);
    unsigned char* dn = F.ws + WS_RA + (size_t)unit * DN_BYTES;
    const rsrc_t drs = mk_rsrc_u(dn, DN_BYTES); const int v16 = lane * 16, v8 = lane * 8;
    LAS unsigned char* raw = F.lds + F.wave * C1_WAVE_BYTES;
    LAS float* AT = (LAS float*)raw;
    LAS float* GC = (LAS float*)(F.lds + C1_EXTRA + MS_WAVE + F.wave * 512);
    const LAS float* CW = (const LAS float*)(F.lds + C1_EXTRA + MS_CONVW);
    const LAS unsigned char* rawl = raw + r * RS + 8 * kq;
    {
        float gv = ((const float*)(F.ws + WS_G))[(size_t)(tok0 + lane) * 4 + h];
        const float bt = ((const float*)(F.ws + WS_BETA))[(size_t)(tok0 + lane) * 4 + h];
#pragma unroll
        for (int off = 1; off < 64; off <<= 1) { const float t = __shfl_up(gv, off); if (lane >= off) gv += t; }
        const float glast = __shfl(gv, 63);
        GC[lane] = gv; GC[64 + lane] = bt;
        float* gt = (float*)(dn + DN_G);
        gt[lane] = bt; gt[64 + lane] = __expf(gv); gt[128 + lane] = __expf(glast - gv); gt[192 + lane] = __expf(glast);
    }
    bf16x8 sel0, sel1;
    {
        unsigned w0[2] = {0u, 0u};
        if (kq == (r >> 2)) { const int j = r & 3; w0[j >> 1] = (j & 1) ? 0x3F800000u : 0x00003F80u; }
        sel0 = mk8(w0[0], w0[1], 0u, 0u); sel1 = mk8(0u, 0u, w0[0], w0[1]);
    }
    const f32x4 z4 = {0.f, 0.f, 0.f, 0.f};
    const rsrc_t urs = mk_rsrc_u(U + (size_t)(b * SEQ) * UW, SEQ * UW * 2);
    stage_store(svv, raw, lane);
#pragma unroll 1
    for (int rt = 0; rt < 4; ++rt) {
        bf16x8 P[4]; conv_tile<false>(rawl + rt * 16 * RS, CW + 2 * 512 + 4 * kq, 1.0f, P);
        u32x2 vo[8];
#pragma unroll
        for (int et = 0; et < 8; ++et) { const f32x4 d = MFMA16(P[et >> 1], (et & 1) ? sel1 : sel0, z4); vo[et] = (u32x2){pk2(d[0], d[1]), pk2(d[2], d[3])}; }
#pragma unroll
        for (int et = 0; et < 8; ++et) BST64(vo[et], drs, v8, DN_V + (et * 4 + rt) * 512);
    }
    stage_raw(urs, 512 + h * DH, n, raw, lane);
    bf16x8 kf[4][4];
#pragma unroll
    for (int rt = 0; rt < 4; ++rt) {
        __builtin_amdgcn_sched_barrier(0);
        conv_tile<true>(rawl + rt * 16 * RS, CW + 512 + 4 * kq, 1.0f, kf[rt]);
#pragma unroll
        for (int kc = 0; kc < 4; ++kc) BST128(kf[rt][kc], drs, v16, DN_K + (rt * 4 + kc) * 1024);
        __builtin_amdgcn_sched_barrier(0);
    }
#pragma unroll
    for (int dt = 0; dt < 8; ++dt)
#pragma unroll
        for (int cc = 0; cc < 2; ++cc) {
            const f32x4 d0 = MFMA16(kf[2 * cc][dt >> 1], (dt & 1) ? sel1 : sel0, z4);
            const f32x4 d1 = MFMA16(kf[2 * cc + 1][dt >> 1], (dt & 1) ? sel1 : sel0, z4);
            BST128(pack8(d0, d1), drs, v16, DN_KT + (dt * 2 + cc) * 1024);
        }
    stage_raw(urs, h * DH, n, raw, lane);
#pragma unroll
    for (int ct = 0; ct < 4; ++ct) {
        __builtin_amdgcn_sched_barrier(0);
        bf16x8 qf[4]; conv_tile<true>(rawl + ct * 16 * RS, CW + 4 * kq, 0.08838834764831845f, qf);
#pragma unroll
        for (int kc = 0; kc < 4; ++kc) BST128(qf[kc], drs, v16, DN_Q + (ct * 4 + kc) * 1024);
        const float gcc = GC[16 * ct + r]; const int c = 16 * ct + r;
        f32x4 tl[4];
#pragma unroll
        for (int ctp = 0; ctp < 4; ++ctp) {
            if (ctp <= ct) {
                f32x4 p = z4;
#pragma unroll
                for (int kc = 0; kc < 4; ++kc) p = MFMA16(kf[ctp][kc], qf[kc], p);
                const f32x4 gp = *(const LAS f32x4*)(GC + 16 * ctp + 4 * kq);
#pragma unroll
                for (int i = 0; i < 4; ++i) { const int cp = 16 * ctp + 4 * kq + i; tl[ctp][i] = (c >= cp) ? p[i] * __expf(gcc - gp[i]) : 0.f; }
            } else tl[ctp] = z4;
        }
        BST128(pack8(tl[0], tl[1]), drs, v16, DN_QK + ct * 1024);
        if (ct >= 2) BST128(pack8(tl[2], tl[3]), drs, v16, DN_QK + (2 + ct) * 1024);
    }
#pragma unroll
    for (int jt = 0; jt < 4; ++jt) {
        const f32x4 gj = *(const LAS f32x4*)(GC + 16 * jt + 4 * kq), bj = *(const LAS f32x4*)(GC + 64 + 16 * jt + 4 * kq);
#pragma unroll
        for (int ctp = 0; ctp <= jt; ++ctp) {
            f32x4 g = z4;
#pragma unroll
            for (int kc = 0; kc < 4; ++kc) g = MFMA16(kf[jt][kc], kf[ctp][kc], g);
            const float gcp = GC[16 * ctp + r]; const int cp = 16 * ctp + r;
            f32x4 o;
#pragma unroll
            for (int i = 0; i < 4; ++i) { const int j = 16 * jt + 4 * kq + i; o[i] = (j > cp) ? bj[i] * g[i] * __expf(gj[i] - gcp) : 0.f; }
            *(LAS f32x4*)(AT + cp * 64 + 16 * jt + 4 * kq) = o;
        }
    }
    LDS_WAIT(); asm volatile("" ::: "memory");
    {
        const int blk = lane >> 4, cq = lane & 15;
        float t[16];
#pragma unroll
        for (int c = 0; c < 16; ++c) t[c] = (c == cq) ? 1.f : 0.f;
        const LAS float* ab = AT + (16 * blk) * 64 + 16 * blk;
#pragma unroll
        for (int j = 0; j < 15; ++j)
#pragma unroll
            for (int c4 = (j + 1) >> 2; c4 < 4; ++c4) { const f32x4 a = *(const LAS f32x4*)(ab + j * 64 + 4 * c4);
#pragma unroll
                for (int i = 0; i < 4; ++i) if (4 * c4 + i > j) t[4 * c4 + i] -= a[i] * t[j]; }
        LAS unsigned char* DL = raw + 16384;
        u32x4 d0 = {pk2(t[0], t[1]), pk2(t[2], t[3]), pk2(t[4], t[5]), pk2(t[6], t[7])}, d1 = {pk2(t[8], t[9]), pk2(t[10], t[11]), pk2(t[12], t[13]), pk2(t[14], t[15])};
        *(LAS u32x4*)(DL + lane * 32) = d0; *(LAS u32x4*)(DL + lane * 32 + 16) = d1;
        LDS_WAIT(); asm volatile("" ::: "memory");
        f32x4 Z[4][4];
        f32x4 eye;
#pragma unroll
        for (int i = 0; i < 4; ++i) eye[i] = (4 * kq + i == r) ? 1.f : 0.f;
#pragma unroll
        for (int cb = 3; cb >= 0; --cb) {
            const u32x2 dl = *(const LAS u32x2*)(DL + ((cb * 16 + r) * 16 + 4 * kq) * 2);
            const bf16x8 Df = mk8(dl[0], dl[1], 0u, 0u);
            f32x4 R[4];
#pragma unroll
            for (int nt = 0; nt < 4; ++nt) R[nt] = (nt == cb) ? eye : z4;
#pragma unroll
            for (int t0 = cb + 1; t0 <= 3; t0 += 2) {
                const int t1 = t0 + 1;
                const f32x4 a0 = *(const LAS f32x4*)(AT + (16 * cb + r) * 64 + 16 * t0 + 4 * kq);
                f32x4 a1 = z4; if (t1 <= 3) a1 = *(const LAS f32x4*)(AT + (16 * cb + r) * 64 + 16 * t1 + 4 * kq);
                const bf16x8 Af = pack8(-a0, -a1);
#pragma unroll
                for (int nt = t0; nt < 4; ++nt) R[nt] = MFMA16(Af, pack8(Z[t0][nt], (t1 <= nt) ? Z[t1 <= 3 ? t1 : 3][nt] : z4), R[nt]);
            }
#pragma unroll
            for (int nt = cb; nt < 4; ++nt) Z[cb][nt] = MFMA16(Df, pack8(R[nt], z4), z4);
        }
#pragma unroll
        for (int f = 0; f < 6; ++f) {
            const int rt = f < 4 ? f : f - 2, cc = f < 4 ? 0 : 1;
            const f32x4 lo = (rt >= 2 * cc) ? Z[2 * cc][rt] : z4, hi = (rt >= 2 * cc + 1) ? Z[2 * cc + 1][rt] : z4;
            BST128(pack8(lo, hi), drs, v16, DN_T + f * 1024);
        }
    }
    LDS_WAIT(); asm volatile("" ::: "memory");
}

DI void ring_dma(const unsigned char* blk, LAS unsigned char* buf, int wave, int lane, bool skip_q) {
#pragma unroll
    for (int i = 0; i < 10; ++i) {
        const int c = wave + 8 * i;
        if (c < 77 && !(skip_q && ((c >= 32 && c < 48) || (c >= 54 && c < 60))))
            __builtin_amdgcn_global_load_lds((const unsigned*)(blk + c * 1024 + lane * 16), (LAS unsigned*)(buf + c * 1024), 16, 0, 0);
    }
}
template <int NT, bool OUT>
DI void slice_step(const LAS unsigned char* img, int lane, int rq, int sl, f32x4 (&S)[NT][8], f32x4 (&O)[4]) {
    const f32x4 z4 = {0.f, 0.f, 0.f, 0.f};
    const LAS unsigned char* fl = img + lane * 16;
    const LAS float* gt = (const LAS float*)(img + DN_G);
#define GT_BT(ct) (*(const LAS f32x4*)(gt + 16 * (ct) + 4 * rq))
#define GT_EG(ct) (*(const LAS f32x4*)(gt + 64 + 16 * (ct) + 4 * rq))
#define GT_ED(ct) (*(const LAS f32x4*)(gt + 128 + 16 * (ct) + 4 * rq))
    const float gl = gt[192];
    bf16x8 Sb[NT][4];
#pragma unroll
    for (int t = 0; t < NT; ++t)
#pragma unroll
        for (int kc = 0; kc < 4; ++kc) Sb[t][kc] = pack8(S[t][2 * kc], S[t][2 * kc + 1]);
    f32x4 X[NT][4], O1[4];
#pragma unroll
    for (int ct = 0; ct < 4; ++ct) {
#pragma unroll
        for (int t = 0; t < NT; ++t) X[t][ct] = z4;
        O1[ct] = z4;
#pragma unroll
        for (int kc = 0; kc < 4; ++kc) {
            const bf16x8 a = *(const LAS bf16x8*)(fl + DN_K + (ct * 4 + kc) * 1024);
#pragma unroll
            for (int t = 0; t < NT; ++t) X[t][ct] = MFMA16(a, Sb[t][kc], X[t][ct]);
            if (OUT) O1[ct] = MFMA16(Sb[0][kc], *(const LAS bf16x8*)(fl + DN_Q + (ct * 4 + kc) * 1024), O1[ct]);
        }
    }
    bf16x8 Yb[NT][2];
#pragma unroll
    for (int t = 0; t < NT; ++t) {
        f32x4 Y[4];
#pragma unroll
        for (int ct = 0; ct < 4; ++ct) {
            const f32x4 btc = GT_BT(ct), egc = GT_EG(ct);
            if (t == 0) { const u32x2 vv = *(const LAS u32x2*)(img + DN_V + (sl * 4 + ct) * 512 + lane * 8);
                const f32x4 v = {bflo(vv[0]), bfhi(vv[0]), bflo(vv[1]), bfhi(vv[1])};
                Y[ct] = btc * (v - egc * X[t][ct]); }
            else Y[ct] = -(btc * egc) * X[t][ct];
        }
        Yb[t][0] = pack8(Y[0], Y[1]); Yb[t][1] = pack8(Y[2], Y[3]);
    }
    f32x4 Vn[NT][4];
#pragma unroll
    for (int ct = 0; ct < 4; ++ct) {
        const bf16x8 a0 = *(const LAS bf16x8*)(fl + DN_T + ct * 1024);
#pragma unroll
        for (int t = 0; t < NT; ++t) Vn[t][ct] = MFMA16(a0, Yb[t][0], z4);
        if (ct >= 2) { const bf16x8 a1 = *(const LAS bf16x8*)(fl + DN_T + (2 + ct) * 1024);
#pragma unroll
            for (int t = 0; t < NT; ++t) Vn[t][ct] = MFMA16(a1, Yb[t][1], Vn[t][ct]); }
    }
    if (OUT) {
        const bf16x8 Vnb0 = pack8(Vn[0][0], Vn[0][1]), Vnb1 = pack8(Vn[0][2], Vn[0][3]);
#pragma unroll
        for (int ct = 0; ct < 4; ++ct) { f32x4 o2 = MFMA16(Vnb0, *(const LAS bf16x8*)(fl + DN_QK + ct * 1024), z4);
            if (ct >= 2) o2 = MFMA16(Vnb1, *(const LAS bf16x8*)(fl + DN_QK + (2 + ct) * 1024), o2);
            O[ct] = gt[64 + 16 * ct + (lane & 15)] * O1[ct] + o2; }
    }
    bf16x8 Vsb[NT][2];
#pragma unroll
    for (int t = 0; t < NT; ++t) { Vsb[t][0] = pack8(GT_ED(0) * Vn[t][0], GT_ED(1) * Vn[t][1]); Vsb[t][1] = pack8(GT_ED(2) * Vn[t][2], GT_ED(3) * Vn[t][3]); }
#pragma unroll
    for (int dt = 0; dt < 8; ++dt) {
#pragma unroll
        for (int t = 0; t < NT; ++t) S[t][dt] = S[t][dt] * gl;
#pragma unroll
        for (int cc = 0; cc < 2; ++cc) { const bf16x8 a = *(const LAS bf16x8*)(fl + DN_KT + (dt * 2 + cc) * 1024);
#pragma unroll
            for (int t = 0; t < NT; ++t) S[t][dt] = MFMA16(a, Vsb[t][cc], S[t][dt]); }
    }
#undef GT_BT
#undef GT_EG
#undef GT_ED
}
DI void scan_s1(Frame& F, int u) {
    const int lane = F.lane, n16 = lane & 15, rq = lane >> 4, sl = F.wave;
    const f32x4 z4 = {0.f, 0.f, 0.f, 0.f};
    const unsigned char* blk0 = F.ws + WS_RA + (size_t)(u * 8) * DN_BYTES;
    f32x4 S[2][8], Odummy[4];
#pragma unroll
    for (int dt = 0; dt < 8; ++dt) { S[0][dt] = z4;
#pragma unroll
        for (int i = 0; i < 4; ++i) S[1][dt][i] = (16 * dt + 4 * rq + i == 16 * sl + n16) ? 1.f : 0.f; }
    ring_dma(blk0, F.lds, F.wave, lane, true);
    VM_WAIT(); __builtin_amdgcn_s_barrier();
#pragma unroll 1
    for (int n = 0; n < 8; ++n) {
        if (n + 1 < 8) ring_dma(blk0 + (size_t)(n + 1) * DN_BYTES, F.lds + ((n + 1) & 1) * RING_IMG, F.wave, lane, true);
        slice_step<2, false>(F.lds + (n & 1) * RING_IMG, lane, rq, sl, S, Odummy);
        VM_WAIT(); LDS_WAIT(); __builtin_amdgcn_s_barrier();
    }
    float* qg = (float*)(F.ws + WS_QG) + ((size_t)(u * 8 + sl) * 8) * 256;
#pragma unroll
    for (int dt = 0; dt < 8; ++dt) *(f32x4*)(qg + dt * 256 + lane * 4) = S[0][dt];
    LAS unsigned char* pt = F.lds + F.wave * 4096;
#pragma unroll
    for (int dt = 0; dt < 8; ++dt) { u32x2 o = {pk2(S[1][dt][0], S[1][dt][1]), pk2(S[1][dt][2], S[1][dt][3])}; *(LAS u32x2*)(pt + n16 * 256 + (16 * dt + 4 * rq) * 2) = o; }
    LDS_WAIT(); asm volatile("" ::: "memory");
    unsigned char* pg = F.ws + WS_PG + (size_t)u * 32768;
    const int r = lane & 15, kq = lane >> 4;
#pragma unroll
    for (int dt = 0; dt < 8; ++dt) {
        const LAS unsigned short* p = (const LAS unsigned short*)(pt + (4 * kq) * 256 + (16 * dt + r) * 2);
        u32x2 o = {(unsigned)p[0] | ((unsigned)p[128] << 16), (unsigned)p[256] | ((unsigned)p[384] << 16)};
        *(u32x2*)(pg + (dt * 4 + (sl >> 1)) * 1024 + lane * 16 + (sl & 1) * 8) = o;
    }
    LDS_WAIT(); asm volatile("" ::: "memory");
}
DI void scan_s2(Frame& F, int s) {
    const int lane = F.lane, sl = F.wave;
    const f32x4 z4 = {0.f, 0.f, 0.f, 0.f};
    f32x4 S[8], Q[2][8];
#pragma unroll
    for (int dt = 0; dt < 8; ++dt) S[dt] = z4;
    const unsigned char* pg0 = F.ws + WS_PG + (size_t)(s * 16) * 32768;
    float* qg0 = (float*)(F.ws + WS_QG) + ((size_t)((s * 16) * 8 + sl) * 8) * 256;
#define S2_DMA(g, bufi) do { _Pragma("unroll") for (int i = 0; i < 4; ++i) { const int c = F.wave + 8 * i; \
        __builtin_amdgcn_global_load_lds((const unsigned*)(pg0 + (size_t)(g) * 32768 + c * 1024 + lane * 16), (LAS unsigned*)(F.lds + (bufi) * 32768 + c * 1024), 16, 0, 0); } } while (0)
#define S2_LDQ(g, qi) do { _Pragma("unroll") for (int dt = 0; dt < 8; ++dt) Q[qi][dt] = *(const f32x4*)(qg0 + (size_t)(g) * 16384 + dt * 256 + lane * 4); } while (0)
    S2_LDQ(0, 0); S2_DMA(0, 0); S2_LDQ(1, 1); S2_DMA(1, 1);
    VM_WAIT(); __builtin_amdgcn_s_barrier();
#pragma unroll 1
    for (int g2 = 0; g2 < 16; g2 += 2)
#pragma unroll
    for (int qi = 0; qi < 2; ++qi) {
        const int g = g2 + qi;
        if (g > 0) {
#pragma unroll
            for (int dt = 0; dt < 8; ++dt) *(f32x4*)(qg0 + (size_t)(g - 1) * 16384 + dt * 256 + lane * 4) = S[dt];
        }
        const LAS unsigned char* fl = F.lds + (g & 3) * 32768 + lane * 16;
        bf16x8 Sb[4];
#pragma unroll
        for (int kc = 0; kc < 4; ++kc) Sb[kc] = pack8(S[2 * kc], S[2 * kc + 1]);
#pragma unroll
        for (int dt = 0; dt < 8; ++dt) { f32x4 a = Q[qi][dt];
#pragma unroll
            for (int kc = 0; kc < 4; ++kc) a = MFMA16(*(const LAS bf16x8*)(fl + (dt * 4 + kc) * 1024), Sb[kc], a);
            S[dt] = a; }
        __builtin_amdgcn_sched_barrier(0);
        if (g + 2 < 16) { S2_LDQ(g + 2, qi); S2_DMA(g + 2, (g + 2) & 3); }
        __builtin_amdgcn_sched_barrier(0);
        if (g + 2 < 16) { if (g == 0) asm volatile("s_waitcnt vmcnt(12)" ::: "memory"); else asm volatile("s_waitcnt vmcnt(20)" ::: "memory"); }
        else asm volatile("s_waitcnt vmcnt(8)" ::: "memory");
        __builtin_amdgcn_sched_barrier(0);
        LDS_WAIT(); __builtin_amdgcn_s_barrier();
    }
    VM_WAIT();
#undef S2_DMA
#undef S2_LDQ
}
constexpr int PSUM_OFF = 2 * RING_IMG;
static_assert(PSUM_OFF + 4096 <= MISC_OFF, "LDS map");
DI void scan_s3(Frame& F, int l, int u) {
    const int lane = F.lane, n16 = lane & 15, rq = lane >> 4, sl = F.wave, s = u >> 4, g = u & 15, b = s >> 2, h = s & 3;
    bf16_t* U = (bf16_t*)(F.ws + WS_RB);
    const unsigned char* blk0 = F.ws + WS_RA + (size_t)(u * 8) * DN_BYTES;
    LAS float* psum = (LAS float*)(F.lds + PSUM_OFF);
    const float onw = IN_(F, 6)[l * DH + sl * 16 + n16];
    f32x4 S[1][8], O[4], Op[4]; u32x2 zp[4], zn[4];
    const f32x4 onw4 = *(const f32x4*)(IN_(F, 6) + l * DH + sl * 16 + 4 * rq);
    const float* sst = (const float*)(F.ws + WS_QG) + ((size_t)((u - 1) * 8 + sl) * 8) * 256;
#pragma unroll
    for (int dt = 0; dt < 8; ++dt) S[0][dt] = g > 0 ? *(const f32x4*)(sst + dt * 256 + lane * 4) : (f32x4){0.f, 0.f, 0.f, 0.f};
    ring_dma(blk0, F.lds, F.wave, lane, false);
    VM_WAIT(); __builtin_amdgcn_s_barrier();
#pragma unroll 1
    for (int n = 0; n <= 8; ++n) {
        if (n + 1 < 8) ring_dma(blk0 + (size_t)(n + 1) * DN_BYTES, F.lds + ((n + 1) & 1) * RING_IMG, F.wave, lane, false);
        if (n < 8) {
            const bf16_t* zb = U + (size_t)(b * SEQ + (g * 8 + n) * CHK + n16) * UW + 1536 + h * DH + sl * 16 + 4 * rq;
#pragma unroll
            for (int ct = 0; ct < 4; ++ct) zn[ct] = *(const u32x2*)(zb + (size_t)(16 * ct) * UW);
        }
        __builtin_amdgcn_sched_barrier(0);
        if (n > 0) {
            bf16_t* yb = U + (size_t)(b * SEQ + (g * 8 + n - 1) * CHK + n16) * UW + 512 + h * DH + sl * 16 + 4 * rq;
            const LAS float* ps = psum + ((n - 1) & 1) * 512;
#pragma unroll
            for (int ct = 0; ct < 4; ++ct) {
                float q = ps[16 * ct + n16];
#pragma unroll
                for (int w = 1; w < 8; ++w) q += ps[w * 64 + 16 * ct + n16];
                const float rs = __builtin_amdgcn_rsqf(q * (1.0f / DH) + EPS);
                const f32x4 o = Op[ct] * rs * onw4;
                const f32x4 yy = o * silu4((f32x4){bflo(zp[ct][0]), bfhi(zp[ct][0]), bflo(zp[ct][1]), bfhi(zp[ct][1])}); const float y0 = yy[0], y1 = yy[1], y2 = yy[2], y3 = yy[3];
                if (l == G2F8_L) *(unsigned*)(F.ws + WS_A8 + (size_t)(b * SEQ + (g * 8 + n - 1) * CHK + n16 + 16 * ct) * DM + h * DH + sl * 16 + 4 * rq) = pk4f8(F8_SA * y0, F8_SA * y1, F8_SA * y2, F8_SA * y3);
                else { u32x2 yv = {pk2(y0, y1), pk2(y2, y3)}; *(u32x2*)(yb + (size_t)(16 * ct) * UW) = yv; }
            }
        }
        if (n < 8) {
            slice_step<1, true>(F.lds + (n & 1) * RING_IMG, lane, rq, sl, S, O);
            LAS float* pw = psum + (n & 1) * 512 + sl * 64;
#pragma unroll
            for (int ct = 0; ct < 4; ++ct) {
                float q = (O[ct][0] * O[ct][0] + O[ct][1] * O[ct][1]) + (O[ct][2] * O[ct][2] + O[ct][3] * O[ct][3]);
                q += __shfl_xor(q, 16); q += __shfl_xor(q, 32);
                if (rq == 0) pw[16 * ct + n16] = q;
                Op[ct] = O[ct]; zp[ct] = zn[ct];
            }
        }
        VM_WAIT(); LDS_WAIT(); __builtin_amdgcn_s_barrier();
    }
}

DI void conformer_unit(Frame& F, int l, int unit) {
    const int cp = F.tid & 255, fh = F.tid >> 8, tok0 = unit * 64 + fh * 32, tl0 = tok0 & (SEQ - 1), ch = 2 * cp;
    bf16_t* U = (bf16_t*)(F.ws + WS_RB);
    const rsrc_t urs = mk_rsrc(U + (size_t)((unit * 64) & ~(SEQ - 1)) * UW, SEQ * UW * 2);
    const float* wdw = IN_(F, 7) + (size_t)l * 31 * 512;
    LAS float* cb = (LAS float*)F.lds;
    f32x2 w[31];
#pragma unroll
    for (int i = 0; i < 31; ++i) w[i] = *(const f32x2*)(wdw + i * 512 + ch);
    const f32x2 bias = *(const f32x2*)(IN_(F, 8) + l * 512 + ch);
    __syncthreads();
    unsigned xin[2][46];
#define CF_LOAD(pp) do { const int tl_ = tl0 + 16 * (pp); _Pragma("unroll") for (int i = 0; i < 46; ++i) xin[pp][i] = __builtin_amdgcn_raw_buffer_load_b32(urs, (tl_ - 30 + i) * (UW * 2) + (2048 + ch) * 2, 0, 0); } while (0)
    CF_LOAD(0);
#pragma unroll
    for (int p = 0; p < 2; ++p) {
        if (p == 0) CF_LOAD(1);
        __builtin_amdgcn_sched_barrier(0);
#pragma unroll
        for (int j = 0; j < 16; ++j) {
            f32x2 a = bias;
#pragma unroll
            for (int tap = 0; tap < 31; ++tap) { const f32x2 x = {bflo(xin[p][j + tap]), bfhi(xin[p][j + tap])}; a += w[tap] * x; }
            *(LAS f32x2*)(cb + (fh * 32 + 16 * p + j) * 512 + ch) = a;
        }
        __builtin_amdgcn_sched_barrier(0);
    }
#undef CF_LOAD
    __syncthreads();
    const float* lg = IN_(F, 9) + l * 512; const float* lb = IN_(F, 10) + l * 512;
    const f32x4 g0 = *(const f32x4*)(lg + 8 * F.lane), g1 = *(const f32x4*)(lg + 8 * F.lane + 4), b0 = *(const f32x4*)(lb + 8 * F.lane), b1 = *(const f32x4*)(lb + 8 * F.lane + 4);
#pragma unroll 2
    for (int jj = 0; jj < 8; ++jj) {
        const int j = F.wave * 8 + jj;
        const f32x4 a = *(const LAS f32x4*)(cb + j * 512 + 8 * F.lane), b = *(const LAS f32x4*)(cb + j * 512 + 8 * F.lane + 4);
        const float mu = wave_sum((a[0] + a[1]) + (a[2] + a[3]) + (b[0] + b[1]) + (b[2] + b[3])) * (1.0f / 512.0f);
        const f32x4 da = a - mu, db = b - mu;
        const float var = wave_sum((da[0] * da[0] + da[1] * da[1]) + (da[2] * da[2] + da[3] * da[3]) + (db[0] * db[0] + db[1] * db[1]) + (db[2] * db[2] + db[3] * db[3])) * (1.0f / 512.0f);
        const float rs = __builtin_amdgcn_rsqf(var + EPS);
        const f32x4 oa = silu4(da * (g0 * rs) + b0), ob = silu4(db * (g1 * rs) + b1);
        const float o[8] = {oa[0], oa[1], oa[2], oa[3], ob[0], ob[1], ob[2], ob[3]};
        if (l == G2F8_L) { u32x2 ov = {pk4f8(F8_SA * o[0], F8_SA * o[1], F8_SA * o[2], F8_SA * o[3]), pk4f8(F8_SA * o[4], F8_SA * o[5], F8_SA * o[6], F8_SA * o[7])};
            *(u32x2*)(F.ws + WS_A8 + (size_t)(unit * 64 + j) * DM + 512 + 8 * F.lane) = ov; }
        else { u32x4 ov = {pk2(o[0], o[1]), pk2(o[2], o[3]), pk2(o[4], o[5]), pk2(o[6], o[7])};
            *(u32x4*)(U + (size_t)(unit * 64 + j) * UW + 1024 + 8 * F.lane) = ov; }
    }
}
#define IN(k) (lo <= (k) && (k) < hi)
#define SEAM(k) do { if (IN(k) && IN((k) + 1)) xcd_barrier(bar); } while (0)
#define PHASE_FRAME() Frame P = F; { int z_ = 0; asm volatile("" : "+s"(z_), "+v"(P.tid), "+v"(P.lane)); P.ws = F.ws + z_; P.out = F.out + z_; }
template <int l> DI void layer_phases(Frame& F, const XcdBarrier& bar, const int lo, const int hi) {
        const int pb = 1 + 9 * l;
        if (IN(pb + 0)) {
            PHASE_FRAME();
            if (l == 0) { norm1_pass<0>(P, 0); __syncthreads(); convert_dense<false>(P); }
            else { if (MK_PER_PHASE) build_seg_tables(P, 0); norm1_pass<2>(P, 1); }
        }
        SEAM(pb + 0);
        if (IN(pb + 1)) {
            PHASE_FRAME();
            if (G1F8 && l == 1) {
                pg8::DenseSched S; S.init(P.ws + WS_X8, DM / 2, P.ws + WS_WIN + (size_t)l * 3072 * DM * 2, T_TOK, 3072, DM / 2, P.G, P.bid);
                pg8::EpiG1 E{(bf16_t*)(P.ws + WS_RB), (const float*)(P.ws + WS_RSTD), 1.0f / (F8_SX * F8_SWI)};
                pg8::gemm_phase<true>(P.lds, DM / 2, S, E);
            } else {
                pg8::DenseSched S; S.init(P.ws + WS_XR, DM, (const bf16_t*)(P.ws + WS_WIN) + (size_t)l * 3072 * DM, T_TOK, 3072, DM, P.G, P.bid);
                pg8::EpiG1 E{(bf16_t*)(P.ws + WS_RB), (const float*)(P.ws + WS_RSTD), 1.0f};
                pg8::gemm_phase<false>(P.lds, DM, S, E);
            }
        }
        SEAM(pb + 1);
        if (IN(pb + 2)) {
            PHASE_FRAME();
            const int ub = P.bid * NWAVES; if (ub < 16 * NCHUNK) {
                const int hh = (ub >> 7) & 3;
                u32x4 svv[17];
                { const int unit_ = ub + P.wave, s_ = unit_ >> 7, n_ = unit_ & 127, b_ = s_ >> 2, h_ = s_ & 3;
                  stage_load(mk_rsrc_u((const bf16_t*)(P.ws + WS_RB) + (size_t)(b_ * SEQ) * UW, SEQ * UW * 2), 1024 + h_ * DH, n_, P.lane, svv); }
                __builtin_amdgcn_sched_barrier(0);
                __syncthreads();
                for (int i = P.tid; i < 3 * 4 * 128; i += NTHR) { const int tz = i >> 9, tap = (i >> 7) & 3, d = i & 127;
                    ((LAS float*)(P.lds + C1_EXTRA + MS_CONVW))[i] = IN_(P, 3)[(size_t)l * 4 * 1536 + tap * 1536 + tz * 512 + hh * DH + d]; }
                __syncthreads();
                dn_chunk_local(P, l, ub + P.wave, svv);
                VM_WAIT(); __syncthreads();
                scan_s1(P, ub >> 3);
            }
        }
        SEAM(pb + 2);
        if (IN(pb + 3)) {
            PHASE_FRAME();
            if (P.bid < 16) { scan_s2(P, P.bid); __syncthreads();
                if (l == 0) { Frame Q = P; Q.G = 16; convert_dense<true>(Q); } }
            else if (l == 0) convert_experts(P, 0, (P.bid - 16) * NWAVES + P.wave, (P.G - 16) * NWAVES);
            else convert_queue(P, nullptr);
        }
        SEAM(pb + 3);
        if (IN(pb + 4)) {
            PHASE_FRAME();
            if (P.bid < 256) scan_s3(P, l, P.bid);
            for (int unit = P.bid; unit < T_TOK / 64; unit += P.G) conformer_unit(P, l, unit);
        }
        SEAM(pb + 4);
        if (IN(pb + 5)) {
            PHASE_FRAME();
            if (l == G2F8_L) {
                pg8::DenseSched S; S.init(P.ws + WS_A8, DM / 2, P.ws + WS_WOUT + (size_t)l * DM * DM * 2, T_TOK, DM, DM / 2, P.G, P.bid);
                pg8::EpiRes E{(bf16_t*)(P.ws + WS_XR), 1.0f / (F8_SA * F8_SWO)};
                pg8::gemm_phase<true>(P.lds, DM / 2, S, E);
            } else {
                pg8::DenseSched S; S.init(P.ws + WS_RB + 512 * 2, UW, (const bf16_t*)(P.ws + WS_WOUT) + (size_t)l * DM * DM, T_TOK, DM, DM, P.G, P.bid);
                pg8::EpiRes E{(bf16_t*)(P.ws + WS_XR), 1.0f};
                pg8::gemm_phase<false>(P.lds, DM, S, E);
            }
        }
        SEAM(pb + 5);
        if (IN(pb + 6)) { PHASE_FRAME(); norm2_pass(P, l); }
        SEAM(pb + 6);
        if (IN(pb + 7)) {
            PHASE_FRAME();
            build_seg_tables(P, l);
            pg8::GroupSched<true> S; S.A = (const char*)(P.ws + WS_X8); S.Bt = (const char*)wgu_ptr(P, l); S.list = (const unsigned*)(P.ws + WS_LIST);
            S.tst = misc_i(P, MS_TST); S.cnt = misc_i(P, MS_CNT); S.K = DM / 2; S.ntile = S.tst[NEXP]; S.G = P.G; S.c = P.bid;
            pg8::EpiSwiGLU E{P.ws + WS_HID, (const float*)(P.ws + WS_RSTDL), misc_i(P, MS_CNT)};
            pg8::gemm_phase<true>(P.lds, DM / 2, S, E);
            if (l == 0) { __syncthreads(); unsigned* dn_ = ctl(P) + CW_DONE; if (P.tid == 0) __hip_atomic_fetch_add(dn_, 1u, __ATOMIC_RELAXED, __HIP_MEMORY_SCOPE_AGENT); convert_queue(P, dn_); }
        }
        SEAM(pb + 7);
        if (IN(pb + 8)) {
            PHASE_FRAME();
            if (MK_PER_PHASE) build_seg_tables(P, l);
            pg8::GroupSched<false> S; S.A = (const char*)(P.ws + WS_HID); S.Bt = (const char*)wdn_ptr(P, l); S.list = nullptr;
            S.tst = misc_i(P, MS_TST); S.cnt = misc_i(P, MS_CNT); S.K = DEXP / 2; S.ntile = S.tst[NEXP]; S.G = P.G; S.c = P.bid;
            pg8::EpiDown E{P.ws + WS_RB, (const float*)(P.ws + WS_GATEL), misc_i(P, MS_CNT)};
            pg8::gemm_phase<true>(P.lds, DEXP / 2, S, E);
            if (l == 0) { __syncthreads(); unsigned* dn_ = ctl(P) + CW_DONE + 64; if (P.tid == 0) __hip_atomic_fetch_add(dn_, 1u, __ATOMIC_RELAXED, __HIP_MEMORY_SCOPE_AGENT); convert_queue(P, dn_); }
        }
        SEAM(pb + 8);
}

constexpr int NPHASE = 20;

__global__ void __launch_bounds__(NTHR, 2) mk_fwd(const float* __restrict__ i0, const float* __restrict__ i1, const float* __restrict__ i2, const float* __restrict__ i3, const float* __restrict__ i4, const float* __restrict__ i5, const float* __restrict__ i6, const float* __restrict__ i7, const float* __restrict__ i8, const float* __restrict__ i9, const float* __restrict__ i10, const float* __restrict__ i11, const float* __restrict__ i12, const float* __restrict__ i13, const float* __restrict__ i14, const float* __restrict__ i15, const float* __restrict__ i16, const float* __restrict__ i17, const float* __restrict__ i18, const float* __restrict__ i19, const float* __restrict__ i20, float* out_, unsigned char* ws_, int ph_lo, int ph_hi) {
    extern __shared__ __attribute__((aligned(16))) unsigned char lds_raw[];
    Frame F;
    F.lds = (LAS unsigned char*)lds_raw;
    F.tid = threadIdx.x; F.lane = F.tid & 63; F.wave = __builtin_amdgcn_readfirstlane(F.tid >> 6);
    F.G = gridDim.x; F.bid = blockIdx.x;
    F.in[0] = i0; F.in[1] = i1; F.in[2] = i2; F.in[3] = i3; F.in[4] = i4; F.in[5] = i5; F.in[6] = i6; F.in[7] = i7; F.in[8] = i8; F.in[9] = i9; F.in[10] = i10; F.in[11] = i11; F.in[12] = i12; F.in[13] = i13; F.in[14] = i14; F.in[15] = i15; F.in[16] = i16; F.in[17] = i17; F.in[18] = i18; F.in[19] = i19; F.in[20] = i20;
    F.out = out_; F.ws = ws_;
    if (F.tid < 4) ((LAS unsigned*)(F.lds + MISC_OFF + MS_BAR))[F.tid] = 0u;
    __syncthreads();
    XcdBarrier bar; bar.bar = ctl(F) + CW_BAR; bar.x = 0; bar.st = nullptr;
    if (!MK_PER_PHASE) bar = xcd_barrier_post(ctl(F) + CW_BAR, (volatile LAS unsigned*)(F.lds + MISC_OFF + MS_BAR));
    const int lo = ph_lo, hi = ph_hi;
#define IN(k) (lo <= (k) && (k) < hi)
#define SEAM(k) do { if (IN(k) && IN((k) + 1)) xcd_barrier(bar); } while (0)
#define PHASE_FRAME() Frame P = F; { int z_ = 0; asm volatile("" : "+s"(z_), "+v"(P.tid), "+v"(P.lane)); P.ws = F.ws + z_; P.out = F.out + z_; }

    layer_phases<0>(F, bar, lo, hi);
    layer_phases<1>(F, bar, lo, hi);
    if (IN(19)) { PHASE_FRAME(); if (MK_PER_PHASE) build_seg_tables(P, 1); final_pass(P); }
#undef IN
#undef SEAM
}

extern "C" void kernel_launch(void* const* d_in, const int* in_sizes, int n_in, void* d_out, int out_size, void* d_ws, size_t ws_size, hipStream_t stream) {
    static int grid = 0;
    if (grid == 0) {
        if (n_in != 21 || ws_size < WS_END) { fprintf(stderr, "kernel_launch: unexpected inputs (n_in %d, ws %zu < %zu)\n", n_in, ws_size, (size_t)WS_END); grid = -1; return; }
        int dev = 0, cus = 0, per_cu = 0;
        if (hipGetDevice(&dev) != hipSuccess || hipDeviceGetAttribute(&cus, hipDeviceAttributeMultiprocessorCount, dev) != hipSuccess) { grid = -1; return; }
        if (hipFuncSetAttribute((const void*)mk_fwd, hipFuncAttributeMaxDynamicSharedMemorySize, LDS_BYTES) != hipSuccess) { grid = -1; return; }
        (void)hipOccupancyMaxActiveBlocksPerMultiprocessor(&per_cu, (const void*)mk_fwd, NTHR, LDS_BYTES);
        (void)hipGetLastError();
        grid = cus;
        if (grid < 256) { fprintf(stderr, "kernel_launch: needs >= 256 CUs (one DeltaNet segment per workgroup)\n"); grid = -1; return; }
        if (grid > 256) grid = 256;
    }
    if (grid < 0) return;
    (void)hipMemsetAsync((char*)d_ws + WS_CTL, 0, CTL_BYTES, stream);
    float* o_ = (float*)d_out; unsigned char* w_ = (unsigned char*)d_ws;
#if MK_PER_PHASE
    for (int p = 0; p < NPHASE; ++p) hipLaunchKernelGGL(mk_fwd, dim3(grid), dim3(NTHR), LDS_BYTES, stream, (const float*)d_in[0], (const float*)d_in[1], (const float*)d_in[2], (const float*)d_in[3], (const float*)d_in[4], (const float*)d_in[5], (const float*)d_in[6], (const float*)d_in[7], (const float*)d_in[8], (const float*)d_in[9], (const float*)d_in[10], (const float*)d_in[11], (const float*)d_in[12], (const float*)d_in[13], (const float*)d_in[14], (const float*)d_in[15], (const float*)d_in[16], (const float*)d_in[17], (const float*)d_in[18], (const float*)d_in[19], (const float*)d_in[20], o_, w_, p, p + 1);
#else
    hipLaunchKernelGGL(mk_fwd, dim3(grid), dim3(NTHR), LDS_BYTES, stream, (const float*)d_in[0], (const float*)d_in[1], (const float*)d_in[2], (const float*)d_in[3], (const float*)d_in[4], (const float*)d_in[5], (const float*)d_in[6], (const float*)d_in[7], (const float*)d_in[8], (const float*)d_in[9], (const float*)d_in[10], (const float*)d_in[11], (const float*)d_in[12], (const float*)d_in[13], (const float*)d_in[14], (const float*)d_in[15], (const float*)d_in[16], (const float*)d_in[17], (const float*)d_in[18], (const float*)d_in[19], (const float*)d_in[20], o_, w_, 0, NPHASE);
#endif
}
```
